# Optimizing an MI355X kernel written in HIP

```python
import math
import jax, jax.numpy as jnp
from jax import lax
import numpy as np

D_MODEL = 2048
BATCH = 8
SEQ = 2048
DEPTH = 1

GRID_W = 64
CTX_LEN = 256
HEAD_DIM = 128
N_HEADS = 8
N_KV_HEADS = 2
Q_PER_KV = N_HEADS // N_KV_HEADS
ATTN_W = N_HEADS * HEAD_DIM
KV_W = N_KV_HEADS * HEAD_DIM
POOL_WINDOWS = (2, 4, 8, 16)
N_POOL_GROUPS = len(POOL_WINDOWS)
POOL_W = D_MODEL // 2
POOL_GROUP_W = POOL_W // N_POOL_GROUPS
MIX_W = POOL_W + ATTN_W
PROJ_W = POOL_W + ATTN_W + 2 * KV_W
D_FF = ((8 * D_MODEL // 3 + 255) // 256) * 256
ROPE_THETA = 10000.0
AXIS_ROT = HEAD_DIM // 2
Q_BLOCK = 128
EPS = 1e-6
N_MOD = 6

kernel_name = "hybrid_pool_gqa_dit_block"


def _rmsnorm(x, g):
    xf = x.astype(jnp.float32)
    y = xf * lax.rsqrt(jnp.mean(xf * xf, axis=-1, keepdims=True) + EPS)
    return (y * g.astype(jnp.float32)).astype(x.dtype)


def _split_proj(p):
    pool = p[..., :POOL_W]
    q = p[..., POOL_W:POOL_W + ATTN_W]
    k = p[..., POOL_W + ATTN_W:POOL_W + ATTN_W + KV_W]
    v = p[..., POOL_W + ATTN_W + KV_W:]
    return pool, q, k, v


def _heads_q(q):
    B, T, _ = q.shape
    return q.reshape(B, T, N_KV_HEADS, Q_PER_KV, HEAD_DIM)


def _heads_kv(k):
    B, T, _ = k.shape
    return k.reshape(B, T, N_KV_HEADS, HEAD_DIM)


def _axial_angles(T):
    n_rows = T // GRID_W
    rows = jnp.repeat(jnp.arange(n_rows, dtype=jnp.float32), GRID_W)
    cols = jnp.tile(jnp.arange(GRID_W, dtype=jnp.float32), n_rows)
    freqs = ROPE_THETA ** (-jnp.arange(0, AXIS_ROT, 2, dtype=jnp.float32) / AXIS_ROT)
    ang = jnp.concatenate([rows[:, None] * freqs, cols[:, None] * freqs], axis=-1)
    return jnp.cos(ang), jnp.sin(ang)


def _rope_2d(x, cos, sin):
    extra = x.ndim - 3
    cos = cos.reshape(cos.shape[0], *([1] * extra), cos.shape[-1])
    sin = sin.reshape(sin.shape[0], *([1] * extra), sin.shape[-1])
    xf = x.astype(jnp.float32).reshape(*x.shape[:-1], HEAD_DIM // 2, 2)
    x1, x2 = xf[..., 0], xf[..., 1]
    out = jnp.stack([x1 * cos - x2 * sin, x1 * sin + x2 * cos], axis=-1)
    return out.reshape(x.shape).astype(x.dtype)


def _attend(q, k, v):
    B, T = q.shape[0], q.shape[1]
    nb = T // Q_BLOCK
    scale = 1.0 / math.sqrt(HEAD_DIM)
    qb = q.reshape(B, nb, Q_BLOCK, N_KV_HEADS, Q_PER_KV, HEAD_DIM).transpose(1, 0, 2, 3, 4, 5)

    def one_block(q_blk):
        s = jnp.einsum('bqkgd,bskd->bkgqs', q_blk, k,
                       preferred_element_type=jnp.float32) * scale
        p = jax.nn.softmax(s, axis=-1).astype(v.dtype)
        return jnp.einsum('bkgqs,bskd->bqkgd', p, v)

    o = lax.map(one_block, qb)
    return o.transpose(1, 0, 2, 3, 4, 5).reshape(B, T, ATTN_W)


def _pool_mixer(u, w_grp, scale):
    B, T, _ = u.shape
    uf = u.astype(jnp.float32).reshape(B, T, N_POOL_GROUPS, POOL_GROUP_W)
    cs = jnp.concatenate([jnp.zeros_like(uf[:, :1]), jnp.cumsum(uf, axis=1)], axis=1)
    t = jnp.arange(T)[:, None]
    half = jnp.array(POOL_WINDOWS, dtype=jnp.int32)[None, :] // 2
    lo = jnp.clip(t - half, 0, T)
    hi = jnp.clip(t + half, 0, T)
    gi = jnp.arange(N_POOL_GROUPS)[None, :]
    win_mean = (cs[:, hi, gi] - cs[:, lo, gi]) / (hi - lo).astype(jnp.float32)[None, :, :, None]
    pooled = (win_mean - uf).astype(u.dtype)
    mixed = jnp.einsum('btgc,gcd->btgd', pooled, w_grp).reshape(B, T, POOL_W)
    return mixed * scale


def _swiglu(h, w_gate, w_up, w_down):
    return (jax.nn.silu(h @ w_gate) * (h @ w_up)) @ w_down


def setup_inputs(seed: int = 0) -> dict:
    key = jax.random.key(seed)
    ks = jax.random.split(key, 18)
    f32 = jnp.float32

    def nrm(k, shape, fan_in, mult=1.0):
        return jax.random.normal(k, shape, f32) * (mult * fan_in ** -0.5)

    return {
        "x": jax.random.normal(ks[0], (BATCH, SEQ, D_MODEL), f32),
        "c": jax.random.normal(ks[1], (BATCH, D_MODEL), f32),
        "ctx": jax.random.normal(ks[2], (BATCH, CTX_LEN, D_MODEL), f32),
        "c_ctx": jax.random.normal(ks[3], (D_MODEL,), f32),
        "w_ada": nrm(ks[4], (DEPTH, D_MODEL, N_MOD * D_MODEL), D_MODEL, 0.5),
        "b_ada": 0.02 * jax.random.normal(ks[5], (DEPTH, N_MOD * D_MODEL), f32),
        "norm_mix": 1.0 + 0.05 * jax.random.normal(ks[6], (DEPTH, D_MODEL), f32),
        "norm_ffn": 1.0 + 0.05 * jax.random.normal(ks[7], (DEPTH, D_MODEL), f32),
        "w_in": nrm(ks[8], (DEPTH, D_MODEL, PROJ_W), D_MODEL),
        "pool_w": nrm(ks[9], (DEPTH, N_POOL_GROUPS, POOL_GROUP_W, POOL_GROUP_W), POOL_GROUP_W),
        "pool_scale": 1.0 + 0.1 * jax.random.normal(ks[10], (DEPTH, POOL_W), f32),
        "q_norm": 1.0 + 0.05 * jax.random.normal(ks[11], (DEPTH, HEAD_DIM), f32),
        "k_norm": 1.0 + 0.05 * jax.random.normal(ks[12], (DEPTH, HEAD_DIM), f32),
        "w_out": nrm(ks[13], (DEPTH, MIX_W, D_MODEL), MIX_W),
        "w_gate": nrm(ks[14], (DEPTH, D_MODEL, D_FF), D_MODEL),
        "w_up": nrm(ks[15], (DEPTH, D_MODEL, D_FF), D_MODEL),
        "w_down": nrm(ks[16], (DEPTH, D_FF, D_MODEL), D_FF),
        "final_norm": 1.0 + 0.05 * jax.random.normal(ks[17], (D_MODEL,), f32),
    }


def reference(x, c, ctx, c_ctx, w_ada, b_ada, norm_mix, norm_ffn, w_in, pool_w,
              pool_scale, q_norm, k_norm, w_out, w_gate, w_up, w_down, final_norm):
    T = x.shape[1]
    cos, sin = _axial_angles(T)

    for layer in range(DEPTH):
        mod_lat = jax.nn.silu(c) @ w_ada[layer] + b_ada[layer]
        mod_ctx = jax.nn.silu(c_ctx) @ w_ada[layer] + b_ada[layer]
        sh_m, sc_m, g_m, sh_f, sc_f, g_f = jnp.split(mod_lat, N_MOD, axis=-1)
        csh_m, csc_m, cg_m, csh_f, csc_f, cg_f = jnp.split(mod_ctx, N_MOD, axis=-1)
        last = layer == DEPTH - 1

        hc = _rmsnorm(ctx, norm_mix[layer]) * (1.0 + csc_m) + csh_m
        if last:
            kv_c = hc @ w_in[layer][:, POOL_W + ATTN_W:]
            k_c, v_c = kv_c[..., :KV_W], kv_c[..., KV_W:]
        else:
            p_c, q_c, k_c, v_c = _split_proj(hc @ w_in[layer])
        k_c = _rmsnorm(_heads_kv(k_c), k_norm[layer])
        v_c = _heads_kv(v_c)

        hx = _rmsnorm(x, norm_mix[layer]) * (1.0 + sc_m[:, None]) + sh_m[:, None]
        p_x, q_x, k_x, v_x = _split_proj(hx @ w_in[layer])
        q_x = _rope_2d(_rmsnorm(_heads_q(q_x), q_norm[layer]), cos, sin)
        k_x = _rope_2d(_rmsnorm(_heads_kv(k_x), k_norm[layer]), cos, sin)
        k_all = jnp.concatenate([k_c, k_x], axis=1)
        v_all = jnp.concatenate([v_c, _heads_kv(v_x)], axis=1)
        attn_x = _attend(q_x, k_all, v_all)
        pool_x = _pool_mixer(p_x, pool_w[layer], pool_scale[layer])
        mix_x = jnp.concatenate([pool_x, attn_x], axis=-1) @ w_out[layer]

        if not last:
            q_c = _rmsnorm(_heads_q(q_c), q_norm[layer])
            attn_c = _attend(q_c, k_c, v_c)
            pool_c = _pool_mixer(p_c, pool_w[layer], pool_scale[layer])
            ctx = ctx + cg_m * (jnp.concatenate([pool_c, attn_c], axis=-1) @ w_out[layer])
            hfc = _rmsnorm(ctx, norm_ffn[layer]) * (1.0 + csc_f) + csh_f
            ctx = ctx + cg_f * _swiglu(hfc, w_gate[layer], w_up[layer], w_down[layer])

        x = x + g_m[:, None] * mix_x
        hf = _rmsnorm(x, norm_ffn[layer]) * (1.0 + sc_f[:, None]) + sh_f[:, None]
        x = x + g_f[:, None] * _swiglu(hf, w_gate[layer], w_up[layer], w_down[layer])

    return _rmsnorm(x, final_norm)
```

```cpp
#include <hip/hip_runtime.h>
#include <hip/hip_bf16.h>
#include <hip/hip_cooperative_groups.h>
#include <cstdio>
#include <cstdint>
namespace cg = cooperative_groups;

#ifndef MK_MULTI
#define MK_MULTI 0
#endif

__device__ __forceinline__ int opaque_tid() { int t = threadIdx.x; asm volatile("" : "+v"(t)); return t; }

namespace pg8 {
#define PG8_LAS __attribute__((address_space(3)))
typedef unsigned short bf16_t;
typedef short bf16x8 __attribute__((ext_vector_type(8)));
typedef float f32x4 __attribute__((ext_vector_type(4)));
typedef unsigned u32x4 __attribute__((ext_vector_type(4)));
constexpr int BM = 256, BK = 64, HALF = 128, HTB = HALF * BK * 2, STAGE_BYTES = 8 * HTB, NXCD = 8, WGM = 8;

__host__ __device__ __forceinline__ int lds_byte(int r, int c) { const int st = (r >> 4) * 2 + (c >> 5), rr = r & 15, cc = c & 31, ob = rr * 64 + cc * 2; return st * 1024 + (ob ^ (((ob >> 9) & 1) << 5)); }
__host__ __device__ __forceinline__ void stage_rc(int b, int& R, int& C) { const int st = b / 1024, sb = b % 1024, swz = sb ^ (((sb >> 9) & 1) << 5); R = (st >> 1) * 16 + swz / 64; C = (st & 1) * 32 + (swz % 64) / 2; }
__host__ __device__ __forceinline__ int perm32(int rho) { const int n = rho >> 4, i = rho & 15; return 8 * (i >> 2) + 4 * n + (i & 3); }

struct Unit { int pm, pn; };
struct Gemm { const bf16_t* A; const bf16_t* Bt; int M, N, K, lda, ldb, a_pn_off; };

struct StaticOrder {
    int nM, nN, nwg, G, c;
    __host__ __device__ void init(int M, int N, int G_, int c_) { nM = M / BM; nN = N / BM; nwg = nM * nN; G = G_; c = c_; }
    __host__ __device__ bool next(int i, Unit& u) const {
        const long L = (long)i * G + c; if (L >= nwg) return false;
        int wgid = (int)L; { const int q = nwg / NXCD, r = nwg % NXCD, xcd = wgid % NXCD, off = wgid / NXCD; wgid = (xcd < r ? xcd * (q + 1) : r * (q + 1) + (xcd - r) * q) + off; }
        const int nig = WGM * nN, gid = wgid / nig, fm = gid * WGM, gsz = (nM - fm) < WGM ? (nM - fm) : WGM;
        u.pm = fm + ((wgid % nig) % gsz); u.pn = (wgid % nig) / gsz; return true;
    }
};

__device__ __forceinline__ unsigned cvt_pk_bf16(float lo, float hi) { unsigned r; asm volatile("v_cvt_pk_bf16_f32 %0, %1, %2" : "=v"(r) : "v"(lo), "v"(hi)); return r; }


template <bool HAS_SCALE> struct EpiBf16 {
    static constexpr bool PERM = true;
    bf16_t* O; int ldc; const float* colscale;
    __device__ __forceinline__ void operator()(const f32x4 (&acc)[2][2][4][2], const Unit& u, int wr, int wc, int fr, int fq) const {
        const int row0 = u.pm * BM + wr * 64 + fr; const int col0 = u.pn * BM + wc * 32 + 8 * fq;
#pragma unroll
        for (int bj = 0; bj < 2; ++bj) {
            f32x4 s0 = (f32x4){1.f, 1.f, 1.f, 1.f}, s1 = s0;
            if constexpr (HAS_SCALE) { s0 = *(const f32x4*)(colscale + col0 + bj * HALF); s1 = *(const f32x4*)(colscale + col0 + bj * HALF + 4); }
#pragma unroll
            for (int ai = 0; ai < 2; ++ai)
#pragma unroll
                for (int m = 0; m < 4; ++m) { bf16_t* rowp = O + (size_t)(row0 + ai * HALF + m * 16) * ldc + col0 + bj * HALF;
                    f32x4 v0 = acc[ai][bj][m][0], v1 = acc[ai][bj][m][1];
                    if constexpr (HAS_SCALE) { v0 = v0 * s0; v1 = v1 * s1; }
                    u32x4 w; w.x = cvt_pk_bf16(v0[0], v0[1]); w.y = cvt_pk_bf16(v0[2], v0[3]); w.z = cvt_pk_bf16(v1[0], v1[1]); w.w = cvt_pk_bf16(v1[2], v1[3]);
                    *(u32x4*)rowp = w; }
        }
    }
};
struct EpiSwiGLU {
    static constexpr bool PERM = true;
    bf16_t* H; int ldc;
    __device__ __forceinline__ void operator()(const f32x4 (&acc)[2][2][4][2], const Unit& u, int wr, int wc, int fr, int fq) const {
        const int row0 = u.pm * BM + wr * 64 + fr; const int col0 = u.pn * HALF + wc * 32 + 8 * fq;
#pragma unroll
        for (int ai = 0; ai < 2; ++ai)
#pragma unroll
            for (int m = 0; m < 4; ++m) { bf16_t* rowp = H + (size_t)(row0 + ai * HALF + m * 16) * ldc + col0; float hv[8];
#pragma unroll
                for (int n = 0; n < 2; ++n)
#pragma unroll
                    for (int e = 0; e < 4; ++e) { const float g = acc[ai][0][m][n][e], up = acc[ai][1][m][n][e];
                        const float sg = g * __builtin_amdgcn_rcpf(1.0f + __builtin_amdgcn_exp2f(-1.4426950408889634f * g)); hv[n * 4 + e] = sg * up; }
                u32x4 w; w.x = cvt_pk_bf16(hv[0], hv[1]); w.y = cvt_pk_bf16(hv[2], hv[3]); w.z = cvt_pk_bf16(hv[4], hv[5]); w.w = cvt_pk_bf16(hv[6], hv[7]);
                *(u32x4*)rowp = w; }
    }
};
struct EpiRes {
    static constexpr bool PERM = true;
    const float* base; float* out; const float* gate;
    __device__ __forceinline__ void operator()(const f32x4 (&acc)[2][2][4][2], const Unit& u, int wr, int wc, int fr, int fq) const {
        const int row0 = u.pm * BM + wr * 64 + fr; const int col0 = u.pn * BM + wc * 32 + 8 * fq;
        const float* gp = gate + (size_t)(u.pm >> 3) * 12288 + col0;
        f32x4 gv[2][2];
#pragma unroll
        for (int bj = 0; bj < 2; ++bj)
#pragma unroll
            for (int n = 0; n < 2; ++n) gv[bj][n] = *(const f32x4*)(gp + bj * HALF + 4 * n);
#pragma unroll
        for (int ai = 0; ai < 2; ++ai)
#pragma unroll
            for (int m = 0; m < 4; ++m) { const size_t off = (size_t)(row0 + ai * HALF + m * 16) * 2048 + col0;
#pragma unroll
                for (int bj = 0; bj < 2; ++bj)
#pragma unroll
                    for (int n = 0; n < 2; ++n) { const f32x4 x = *(const f32x4*)(base + off + bj * HALF + 4 * n);
                        *(f32x4*)(out + off + bj * HALF + 4 * n) = x + gv[bj][n] * acc[ai][bj][m][n]; } }
    }
};

template <class Epi, class Sched, bool ALIGN_EPI>
__device__ __forceinline__ void gemm_phase(PG8_LAS unsigned char* lds, const Gemm g, const Sched& S, const Epi& E) {
    const int tid = opaque_tid(), wid = __builtin_amdgcn_readfirstlane(tid >> 6), lane = tid & 63, wr = wid >> 2, wc = wid & 3, fr = lane & 15, fq = lane >> 4;
    const int K = g.K, nt = K / BK;
    unsigned voffA[2], voffB[2];
#pragma unroll
    for (int i = 0; i < 2; ++i) { int R, C; stage_rc(tid * 16 + i * 8192, R, C); const int Rb = Epi::PERM ? ((R & ~31) + perm32(R & 31)) : R;
        voffA[i] = (unsigned)(R * g.lda + C) * 2u; voffB[i] = (unsigned)(Rb * g.ldb + C) * 2u; }
    const size_t kstep = (size_t)(BK * 2);
    const size_t hstepA = (size_t)HALF * g.lda * 2, hstepB = (size_t)HALF * g.ldb * 2;
    const size_t tstepA = 2 * hstepA, tstepB = 2 * hstepB, pnoffA = (size_t)g.a_pn_off * 2;
    const unsigned ldsw = (unsigned)wid * 1024u;
    const int aoff = lds_byte(wr * 64 + fr, fq * 8), boff = lds_byte(wc * 32 + fr, fq * 8);
#define PG8_SA(b, h) (((b) * 2 + (h)) * HTB)
#define PG8_SB(b, h) ((4 + (b) * 2 + (h)) * HTB)
#define PG8_STAGE(bufoff, gbase, voff) do { _Pragma("unroll") for (int _i = 0; _i < 2; ++_i) \
        __builtin_amdgcn_global_load_lds((const unsigned*)((const char*)(gbase) + (voff)[_i]), (PG8_LAS unsigned*)(lds + (bufoff) + ldsw + _i * 8192), 16, 0, 0); } while (0)
#define PG8_LDA(dst, b, h) do { _Pragma("unroll") for (int m = 0; m < 4; ++m) _Pragma("unroll") for (int k = 0; k < 2; ++k) dst[m][k] = *(const PG8_LAS bf16x8*)(lds + PG8_SA(b, h) + aoff + m * 2048 + k * 1024); } while (0)
#define PG8_LDB(dst, b, h) do { _Pragma("unroll") for (int n = 0; n < 2; ++n) _Pragma("unroll") for (int k = 0; k < 2; ++k) dst[n][k] = *(const PG8_LAS bf16x8*)(lds + PG8_SB(b, h) + boff + n * 2048 + k * 1024); } while (0)
#define PG8_MMA(ai, bj, At, Bt) do { __builtin_amdgcn_s_setprio(1); _Pragma("unroll") for (int m = 0; m < 4; ++m) _Pragma("unroll") for (int n = 0; n < 2; ++n) _Pragma("unroll") for (int k = 0; k < 2; ++k) \
        acc[ai][bj][m][n] = __builtin_amdgcn_mfma_f32_16x16x32_bf16(Bt[n][k], At[m][k], acc[ai][bj][m][n], 0, 0, 0); __builtin_amdgcn_s_setprio(0); } while (0)
#define PG8_WAIT_V(n) asm volatile("s_waitcnt vmcnt(" #n ")" ::: "memory")
#define PG8_WAIT_L(n) asm volatile("s_waitcnt lgkmcnt(" #n ")" ::: "memory")
#define PG8_BAR __builtin_amdgcn_s_barrier()
#define PG8_SCHED __builtin_amdgcn_sched_barrier(0)
    Unit cur, nxt; int ui = 0;
    if (!S.next(0, cur)) return;
    f32x4 acc[2][2][4][2];
#pragma unroll
    for (int a = 0; a < 2; ++a)
#pragma unroll
        for (int b = 0; b < 2; ++b)
#pragma unroll
            for (int m = 0; m < 4; ++m)
#pragma unroll
                for (int n = 0; n < 2; ++n) acc[a][b][m][n] = (f32x4){0.f, 0.f, 0.f, 0.f};
    bf16x8 At[4][2], B0[2][2], B1[2][2];
    const char* cA = (const char*)g.A + (size_t)cur.pm * tstepA + (size_t)cur.pn * pnoffA; const char* cB = (const char*)g.Bt + (size_t)cur.pn * tstepB;
    PG8_STAGE(PG8_SB(0, 0), cB, voffB); PG8_STAGE(PG8_SB(0, 1), cB + hstepB, voffB); PG8_STAGE(PG8_SA(0, 0), cA, voffA); PG8_STAGE(PG8_SA(0, 1), cA + hstepA, voffA);
    if (wr == 1) PG8_BAR;
    PG8_WAIT_V(2); PG8_BAR;
    PG8_STAGE(PG8_SB(1, 0), cB + kstep, voffB); PG8_STAGE(PG8_SA(1, 0), cA + kstep, voffA); PG8_STAGE(PG8_SB(1, 1), cB + hstepB + kstep, voffB);
    PG8_WAIT_V(6); PG8_BAR;
    for (;;) {
        const bool has_next = S.next(ui + 1, nxt);
        const char* nA = has_next ? (const char*)g.A + (size_t)nxt.pm * tstepA + (size_t)nxt.pn * pnoffA : cA; const char* nB = has_next ? (const char*)g.Bt + (size_t)nxt.pn * tstepB : cB;
#pragma unroll 1
        for (int t = 0; t < nt; t += 2) {
            const bool last = (t == nt - 2);
            const char* a1 = cA + (size_t)(t + 1) * kstep;
            const char* a2 = last ? nA : cA + (size_t)(t + 2) * kstep; const char* b2 = last ? nB : cB + (size_t)(t + 2) * kstep;
            const char* a3 = a2 + kstep; const char* b3 = b2 + kstep;
            PG8_LDB(B0, 0, 0); PG8_LDB(B1, 0, 1); PG8_SCHED; PG8_LDA(At, 0, 0); PG8_STAGE(PG8_SA(1, 1), a1 + hstepA, voffA);
            PG8_WAIT_V(8); PG8_WAIT_L(0); PG8_BAR; PG8_MMA(0, 0, At, B0); PG8_MMA(0, 1, At, B1); PG8_BAR; PG8_SCHED;
            PG8_LDA(At, 0, 1); PG8_STAGE(PG8_SB(0, 0), b2, voffB); PG8_STAGE(PG8_SB(0, 1), b2 + hstepB, voffB); PG8_STAGE(PG8_SA(0, 0), a2, voffA);
            PG8_WAIT_V(8); PG8_WAIT_L(0); PG8_BAR; PG8_MMA(1, 0, At, B0); PG8_MMA(1, 1, At, B1); PG8_BAR; PG8_SCHED;
            PG8_LDB(B0, 1, 0); PG8_LDB(B1, 1, 1); PG8_SCHED; PG8_LDA(At, 1, 0); PG8_STAGE(PG8_SA(0, 1), a2 + hstepA, voffA);
            PG8_WAIT_V(8); PG8_WAIT_L(0); PG8_BAR; PG8_MMA(0, 0, At, B0); PG8_MMA(0, 1, At, B1); PG8_BAR; PG8_SCHED;
            PG8_LDA(At, 1, 1); PG8_STAGE(PG8_SB(1, 0), b3, voffB); PG8_STAGE(PG8_SB(1, 1), b3 + hstepB, voffB); PG8_STAGE(PG8_SA(1, 0), a3, voffA);
            PG8_WAIT_V(8); PG8_WAIT_L(0); PG8_BAR; PG8_MMA(1, 0, At, B0); PG8_MMA(1, 1, At, B1); PG8_BAR; PG8_SCHED;
        }
        if constexpr (ALIGN_EPI) { if (wr == 0) PG8_BAR; }
        E(acc, cur, wr, wc, fr, fq);
        if (!has_next) break;
#pragma unroll
        for (int a = 0; a < 2; ++a)
#pragma unroll
            for (int b = 0; b < 2; ++b)
#pragma unroll
                for (int m = 0; m < 4; ++m)
#pragma unroll
                    for (int n = 0; n < 2; ++n) acc[a][b][m][n] = (f32x4){0.f, 0.f, 0.f, 0.f};
        cur = nxt; cA = nA; cB = nB; ++ui;
        if constexpr (ALIGN_EPI) { if (wr == 1) PG8_BAR; }
    }
    PG8_WAIT_V(0);
    if constexpr (!ALIGN_EPI) { if (wr == 0) PG8_BAR; }
    PG8_BAR;
#undef PG8_SA
#undef PG8_SB
#undef PG8_STAGE
#undef PG8_LDA
#undef PG8_LDB
#undef PG8_MMA
#undef PG8_WAIT_V
#undef PG8_WAIT_L
#undef PG8_BAR
#undef PG8_SCHED
}
}

namespace att {
using bf16 = __hip_bfloat16;
constexpr int D = 128, NW = 8, QBLK = 32, KVBLK = 64;
constexpr float SCALE = 0.088388347648318440f;
constexpr float THR = 8.f;
constexpr int SDEPTH = 2;
constexpr int LDQ = 1024, LDK = 256, LDO = 2048;
constexpr size_t SHM_V = KVBLK * D * 2, SHM_K = KVBLK * D * 2, SHM_ATTN = 2 * SHM_V + 2 * SHM_K + NW * 64 * 4;
using bf16x8 = __attribute__((ext_vector_type(8))) short;
using s16x4  = __attribute__((ext_vector_type(4))) short;
using f32x16 = __attribute__((ext_vector_type(16))) float;
using u32x4  = __attribute__((ext_vector_type(4))) unsigned;
#define KSWZ(row, colB) ((row) * 256 + ((colB) ^ (((row) & 7) << 4)))
#define SBAR() __builtin_amdgcn_sched_barrier(0)
__device__ __forceinline__ int crow(int r, int hi) { return (r & 3) + 8 * (r >> 2) + 4 * hi; }
__device__ __forceinline__ unsigned cvtpk(float lo, float hi) { unsigned r; asm volatile("v_cvt_pk_bf16_f32 %0, %1, %2" : "=v"(r) : "v"(lo), "v"(hi)); return r; }
__device__ __forceinline__ bf16x8 ld8(const bf16* p) { return *reinterpret_cast<const bf16x8*>(p); }

__device__ __forceinline__ void partialSM(f32x16& p0, f32x16& p1, float& m_reg, float& mn, float& alpha) {
  constexpr float C = SCALE * 1.4426950408889634f;
  float pmax = p0[0]; for (int r = 1; r < 16; ++r) pmax = fmaxf(pmax, p0[r]); for (int r = 0; r < 16; ++r) pmax = fmaxf(pmax, p1[r]);
  { auto rr = __builtin_amdgcn_permlane32_swap(__float_as_uint(pmax), __float_as_uint(pmax), false, false);
    pmax = fmaxf(__uint_as_float(rr[0]), __uint_as_float(rr[1])); }
  if (__builtin_expect(__all(pmax - m_reg <= THR / SCALE), 1)) { mn = m_reg; alpha = 1.f; }
  else { mn = fmaxf(m_reg, pmax); alpha = __builtin_amdgcn_exp2f((m_reg - mn) * C); m_reg = mn; }
  float mnC = -mn * C;
  for (int r = 0; r < 16; ++r) p0[r] = fmaf(p0[r], C, mnC); for (int r = 0; r < 16; ++r) p1[r] = fmaf(p1[r], C, mnC);
  for (int r = 0; r < 16; ++r) p0[r] = __builtin_amdgcn_exp2f(p0[r]);
}
__device__ __forceinline__ void finishSM(f32x16& p0, f32x16& p1, float alpha, float& l_reg, bf16x8& pa0, bf16x8& pa1, bf16x8& pa2, bf16x8& pa3) {
  for (int r = 0; r < 16; ++r) p1[r] = __builtin_amdgcn_exp2f(p1[r]);
  float ps = 0; for (int r = 0; r < 16; ++r) ps += p0[r]; for (int r = 0; r < 16; ++r) ps += p1[r];
  { auto rr = __builtin_amdgcn_permlane32_swap(__float_as_uint(ps), __float_as_uint(ps), false, false);
    ps = __uint_as_float(rr[0]) + __uint_as_float(rr[1]); }
  l_reg = l_reg * alpha + ps;
#define PK4(P, BASE, OUT) do { unsigned a0 = cvtpk(P[BASE + 0], P[BASE + 1]), a1 = cvtpk(P[BASE + 2], P[BASE + 3]);   \
    unsigned b0 = cvtpk(P[BASE + 4], P[BASE + 5]), b1 = cvtpk(P[BASE + 6], P[BASE + 7]);                              \
    auto r0 = __builtin_amdgcn_permlane32_swap(a0, b0, false, false); auto r1 = __builtin_amdgcn_permlane32_swap(a1, b1, false, false); \
    u32x4 w = {r0[0], r1[0], r0[1], r1[1]}; OUT = *reinterpret_cast<bf16x8*>(&w); } while (0)
  PK4(p0, 0, pa0); PK4(p0, 8, pa1); PK4(p1, 0, pa2); PK4(p1, 8, pa3);
#undef PK4
}
__device__ __forceinline__ void qkt(f32x16& p0, f32x16& p1, const bf16* Ks, const bf16x8* qr, int r32, int hi) {
  p0 = f32x16{}; p1 = f32x16{};
  for (int d0 = 0; d0 < 8; ++d0) { int cb = (d0 * 16 + hi * 8) * 2;
    bf16x8 b0 = *reinterpret_cast<const bf16x8*>((const char*)Ks + KSWZ(r32, cb));
    bf16x8 b1 = *reinterpret_cast<const bf16x8*>((const char*)Ks + KSWZ(32 + r32, cb));
    p0 = __builtin_amdgcn_mfma_f32_32x32x16_bf16(b0, qr[d0], p0, 0, 0, 0);
    p1 = __builtin_amdgcn_mfma_f32_32x32x16_bf16(b1, qr[d0], p1, 0, 0, 0); }
}
__device__ __forceinline__ int v_st(int k, int c) { const int kk = (k & ~0xC) | ((k & 4) << 1) | ((k & 8) >> 1); return ((kk >> 3) * 4 + (c >> 5)) * 512 + ((kk & 7) * 32 + (c & 31)) * 2; }
__device__ __forceinline__ int v_rd_base(int lane) { return ((lane & 3) << 3) | (((lane >> 2) & 3) << 6) | (((lane >> 4) & 1) << 5) | (((lane >> 5) & 1) << 8); }
constexpr int v_rd_off(int d0, int ks, int half) { return d0 * 512 + ks * 4096 + half * 2048; }
template <int OFF> __device__ __forceinline__ s16x4 tr_read(int vb) {
  s16x4 r; asm volatile("ds_read_b64_tr_b16 %0, %1 offset:%2" : "=&v"(r) : "v"(vb), "i"(OFF) : "memory"); return r;
}
template <int D0> __device__ __forceinline__ void pv_one(f32x16& od, int vb, bf16x8 pa0, bf16x8 pa1, bf16x8 pa2, bf16x8 pa3) {
  const s16x4 l0 = tr_read<v_rd_off(D0, 0, 0)>(vb), h0 = tr_read<v_rd_off(D0, 0, 1)>(vb), l1 = tr_read<v_rd_off(D0, 1, 0)>(vb), h1 = tr_read<v_rd_off(D0, 1, 1)>(vb);
  const s16x4 l2 = tr_read<v_rd_off(D0, 2, 0)>(vb), h2 = tr_read<v_rd_off(D0, 2, 1)>(vb), l3 = tr_read<v_rd_off(D0, 3, 0)>(vb), h3 = tr_read<v_rd_off(D0, 3, 1)>(vb);
  asm volatile("s_waitcnt lgkmcnt(0)" ::: "memory"); SBAR();
#define PK(L, H) (bf16x8){L[0], L[1], L[2], L[3], H[0], H[1], H[2], H[3]}
  od = __builtin_amdgcn_mfma_f32_32x32x16_bf16(pa0, PK(l0, h0), od, 0, 0, 0);
  od = __builtin_amdgcn_mfma_f32_32x32x16_bf16(pa1, PK(l1, h1), od, 0, 0, 0);
  od = __builtin_amdgcn_mfma_f32_32x32x16_bf16(pa2, PK(l2, h2), od, 0, 0, 0);
  od = __builtin_amdgcn_mfma_f32_32x32x16_bf16(pa3, PK(l3, h3), od, 0, 0, 0);
#undef PK
}
__device__ __forceinline__ void pv_d0(f32x16* o, int vb, bf16x8 pa0, bf16x8 pa1, bf16x8 pa2, bf16x8 pa3) {
  pv_one<0>(o[0], vb, pa0, pa1, pa2, pa3); pv_one<1>(o[1], vb, pa0, pa1, pa2, pa3); pv_one<2>(o[2], vb, pa0, pa1, pa2, pa3); pv_one<3>(o[3], vb, pa0, pa1, pa2, pa3);
}
__device__ __forceinline__ void attn_dense_body(const bf16* __restrict__ Qb, const bf16* __restrict__ Kh, const bf16* __restrict__ Vh,
                                                unsigned short* __restrict__ Ob, int seq, char* lds) {
  const int tid = opaque_tid(), wid = tid >> 6, lane = tid & 63, r32 = lane & 31, hi = lane >> 5;
  bf16* V_lds = (bf16*)lds; bf16* K_lds = (bf16*)(lds + 2 * SHM_V);
  float* ws = (float*)(lds + 2 * SHM_V + 2 * SHM_K) + wid * 64; float* li_l = ws; float* al_l = ws + 32;
  float m_reg = -1e30f, l_reg = 0; f32x16 o[4] = {}; bf16x8 qr[8];
  const bf16* Qw = Qb + (long)(wid * QBLK + r32) * LDQ + hi * 8;
#pragma unroll
  for (int d0 = 0; d0 < 8; ++d0) qr[d0] = ld8(Qw + d0 * 16);
  const int sr = tid >> 4, sc = (tid & 15) * 8, vst0 = v_st(sr, sc), vst1 = v_st(32 + sr, sc);
  const int vb0 = (int)(uintptr_t)V_lds + v_rd_base(lane);
  struct { bf16x8 vs0, vs1, ks0, ks1; } sr_[SDEPTH];
  const unsigned goff0 = (unsigned)(sr * LDK + sc) * 2u, goff1 = goff0 + 32u * LDK * 2u;
#define SLOAD(i, k0) do { const char* vt_ = (const char*)Vh + (size_t)(k0) * (LDK * 2); const char* kt_ = (const char*)Kh + (size_t)(k0) * (LDK * 2); \
    sr_[i].vs0 = *(const bf16x8*)(vt_ + goff0); sr_[i].vs1 = *(const bf16x8*)(vt_ + goff1); \
    sr_[i].ks0 = *(const bf16x8*)(kt_ + goff0); sr_[i].ks1 = *(const bf16x8*)(kt_ + goff1); } while (0)
#define SWRITE(b, i) do { *(bf16x8*)((char*)V_lds + (b) * SHM_V + vst0) = sr_[i].vs0;          \
    *(bf16x8*)((char*)V_lds + (b) * SHM_V + vst1) = sr_[i].vs1; int kc = sc * 2;               \
    *(bf16x8*)((char*)K_lds + (b) * SHM_K + KSWZ(sr, kc)) = sr_[i].ks0;                       \
    *(bf16x8*)((char*)K_lds + (b) * SHM_K + KSWZ(32 + sr, kc)) = sr_[i].ks1; } while (0)
#define SWAIT() do { asm volatile("s_waitcnt vmcnt(4)" ::: "memory"); } while (0)
#define RESC(a) do { if (__any((a) < 1.f)) { if (hi == 0) al_l[r32] = (a); asm volatile("s_waitcnt lgkmcnt(0)" ::: "memory"); \
    for (int d = 0; d < 4; ++d) for (int r = 0; r < 16; ++r) o[d][r] *= al_l[crow(r, hi)]; } } while (0)
  f32x16 pA0, pA1, pB0, pB1; float mnA, mnB, alA, alB; bf16x8 pa0, pa1, pa2, pa3; const int NT = seq / KVBLK;
  constexpr int SE = 0, SO = SDEPTH - 1;
  SLOAD(SE, 0); asm volatile("s_waitcnt vmcnt(0)" ::: "memory"); SWRITE(0, SE); __syncthreads();
  qkt(pA0, pA1, K_lds, qr, r32, hi); partialSM(pA0, pA1, m_reg, mnA, alA);
  SLOAD(SO, KVBLK); if (2 < NT) SLOAD(SE, 2 * KVBLK);
  SWAIT(); SWRITE(1, SO); __syncthreads();
#pragma unroll 1
  for (int j = 1; j + 1 < NT; j += 2) {
    SBAR(); qkt(pB0, pB1, (bf16*)((char*)K_lds + SHM_K), qr, r32, hi);
    finishSM(pA0, pA1, alA, l_reg, pa0, pa1, pa2, pa3); SBAR();
    SLOAD(SO, (j + SDEPTH) * KVBLK); SBAR();
    pv_d0(o, vb0, pa0, pa1, pa2, pa3); partialSM(pB0, pB1, m_reg, mnB, alB);
    __syncthreads(); SWAIT(); SWRITE(0, SE);
    RESC(alB); __syncthreads();
    SBAR(); qkt(pA0, pA1, K_lds, qr, r32, hi);
    finishSM(pB0, pB1, alB, l_reg, pa0, pa1, pa2, pa3); SBAR();
    if (j + 3 < NT) SLOAD(SE, (j + 1 + SDEPTH) * KVBLK); SBAR();
    pv_d0(o, vb0 + (int)SHM_V, pa0, pa1, pa2, pa3); partialSM(pA0, pA1, m_reg, mnA, alA);
    __syncthreads(); SWAIT(); SWRITE(1, SO);
    RESC(alA); __syncthreads();
  }
  SBAR(); qkt(pB0, pB1, (bf16*)((char*)K_lds + SHM_K), qr, r32, hi);
  finishSM(pA0, pA1, alA, l_reg, pa0, pa1, pa2, pa3); SBAR();
  pv_d0(o, vb0, pa0, pa1, pa2, pa3); partialSM(pB0, pB1, m_reg, mnB, alB);
  __syncthreads(); RESC(alB);
  finishSM(pB0, pB1, alB, l_reg, pa0, pa1, pa2, pa3); SBAR();
  pv_d0(o, vb0 + (int)SHM_V, pa0, pa1, pa2, pa3);
  if (hi == 0) li_l[r32] = l_reg; asm volatile("s_waitcnt lgkmcnt(0)" ::: "memory");
  float rli[16];
#pragma unroll
  for (int r = 0; r < 16; ++r) rli[r] = __builtin_amdgcn_rcpf(li_l[crow(r, hi)]);
  unsigned short* Ow = Ob + (long)(wid * QBLK) * LDO;
#pragma unroll
  for (int r = 0; r < 16; ++r) { int orow = crow(r, hi);
#pragma unroll
    for (int d0 = 0; d0 < 4; ++d0) { const float v = o[d0][r] * rli[r]; Ow[(long)orow * LDO + d0 * 32 + r32] = (unsigned short)(cvtpk(v, v) & 0xffffu); } }
#undef SLOAD
#undef SWRITE
#undef SWAIT
#undef RESC
}
#undef KSWZ
#undef SBAR
}

constexpr int DM = 2048, NB = 8, SEQ = 2048, CTXL = 256, PROJ = 2560, DFF = 5632, NMOD = 6 * DM, SKV = CTXL + SEQ;
constexpr int ML = NB * SEQ, MC = NB * CTXL, MT = ML + MC;
constexpr float EPS = 1e-6f;
constexpr int NWAVES = 8, NTHREADS = 512;
constexpr int LDS_BYTES = 147456;
constexpr size_t MiB = 1u << 20;
constexpr size_t WS_MODP = 0;
constexpr size_t WS_MODF = 2 * MiB;
constexpr size_t WS_WIN = 3 * MiB;
constexpr size_t WS_WOUT = 13 * MiB;
constexpr size_t WS_WGU = 21 * MiB;
constexpr size_t WS_WD = 65 * MiB;
constexpr size_t WS_PW = 87 * MiB;
constexpr size_t WS_A = 88 * MiB;
constexpr size_t WS_X1 = 160 * MiB;
constexpr size_t WS_P = 288 * MiB;
constexpr size_t WS_QN = 378 * MiB;
constexpr size_t WS_KALL = 410 * MiB;
constexpr size_t WS_VALL = 419 * MiB;
constexpr size_t WS_POOL = 428 * MiB;
constexpr size_t WS_H = 288 * MiB;
constexpr size_t WS_END = 464 * MiB;

typedef unsigned short bf16raw;
typedef float f32x4 __attribute__((ext_vector_type(4)));
typedef unsigned u32x4 __attribute__((ext_vector_type(4)));
typedef unsigned u32x2 __attribute__((ext_vector_type(2)));
#define LAS __attribute__((address_space(3)))

__device__ __forceinline__ unsigned f2bf(float f) { unsigned u = __builtin_bit_cast(unsigned, f); return (u + 0x7fffu + ((u >> 16) & 1u)) >> 16; }
__device__ __forceinline__ unsigned pk2(float lo, float hi) { return f2bf(lo) | (f2bf(hi) << 16); }
__device__ __forceinline__ float bflo(unsigned w) { return __builtin_bit_cast(float, w << 16); }
__device__ __forceinline__ float bfhi(unsigned w) { return __builtin_bit_cast(float, w & 0xffff0000u); }
__device__ __forceinline__ float wave_sum(float v) {
#pragma unroll
    for (int o = 1; o < 64; o <<= 1) v += __shfl_xor(v, o);
    return v;
}

struct Args { const float* in[18]; float* out; unsigned char* ws; int ph_lo, ph_hi; };
enum { I_X = 0, I_C, I_CTX, I_CCTX, I_WADA, I_BADA, I_NMIX, I_NFFN, I_WIN, I_POOLW, I_POOLS, I_QN, I_KN, I_WOUT, I_WG, I_WU, I_WD, I_FN };

__device__ __forceinline__ void transpose_item(const float* W, int K, int N, bf16raw* WT, int k0, int n0, int drow0, LAS float* scr, int lane) {
#pragma unroll 8
    for (int i = 0; i < 32; ++i) { const int kk = 2 * i + (lane >> 5); scr[kk * 33 + (lane & 31)] = W[(size_t)(k0 + kk) * N + n0 + (lane & 31)]; }
    asm volatile("s_waitcnt lgkmcnt(0)" ::: "memory");
    const int c = lane & 7;
#pragma unroll
    for (int j = 0; j < 4; ++j) { const int n = (lane >> 3) + 8 * j; const LAS float* s = scr + (8 * c) * 33 + n;
        u32x4 o; o.x = pk2(s[0 * 33], s[1 * 33]); o.y = pk2(s[2 * 33], s[3 * 33]); o.z = pk2(s[4 * 33], s[5 * 33]); o.w = pk2(s[6 * 33], s[7 * 33]);
        *(u32x4*)(WT + (size_t)(drow0 + n) * K + k0 + 8 * c) = o; }
    asm volatile("s_waitcnt lgkmcnt(0)" ::: "memory");
}

__device__ __forceinline__ void norm_row_bf16(const float* xrow, bf16raw* orow, const LAS float* scale, const LAS float* shift, int lane) {
    const f32x4* xr = (const f32x4*)xrow + lane;
    f32x4 v[8]; float s = 0.f;
#pragma unroll
    for (int j = 0; j < 8; ++j) { v[j] = xr[64 * j]; s += (v[j].x * v[j].x + v[j].y * v[j].y) + (v[j].z * v[j].z + v[j].w * v[j].w); }
    const float rstd = 1.0f / sqrtf(wave_sum(s) * (1.f / DM) + EPS);
    u32x2* o8 = (u32x2*)orow + lane;
#pragma unroll
    for (int j = 0; j < 8; ++j) { const f32x4 sc = *((const LAS f32x4*)scale + lane + 64 * j), sh = *((const LAS f32x4*)shift + lane + 64 * j);
        const f32x4 y = v[j] * rstd * sc + sh; u32x2 w; w.x = pk2(y.x, y.y); w.y = pk2(y.z, y.w); o8[64 * j] = w; }
}

__global__ void __launch_bounds__(NTHREADS, 2) fwd_megakernel(Args a) {
    extern __shared__ __attribute__((aligned(16))) unsigned char lds[];
    cg::grid_group grid = cg::this_grid();
    const int G = gridDim.x, bx = blockIdx.x;
    const int vcu = (G % 8 == 0) ? (bx % 8) * (G / 8) + bx / 8 : bx;
    const int NGW = G * NWAVES;
#define PHASE_IDS() const int tid = opaque_tid(), lane = tid & 63, wave = __builtin_amdgcn_readfirstlane(tid >> 6), gw = vcu * NWAVES + wave; (void)lane; (void)gw
    typedef const Args __attribute__((address_space(4)))* CArgsP;
    const CArgsP ap0 = (CArgsP)__builtin_amdgcn_kernarg_segment_ptr();
#define ARGP() ({ CArgsP p_ = ap0; asm volatile("" : "+s"(p_)); p_; })
#define INP(i) (ARGP()->in[i])
    unsigned char* ws = ARGP()->ws;
    float* MODP = (float*)(ws + WS_MODP); float* MODF = (float*)(ws + WS_MODF);
    bf16raw* WinT = (bf16raw*)(ws + WS_WIN); bf16raw* WoutT = (bf16raw*)(ws + WS_WOUT); bf16raw* WguT = (bf16raw*)(ws + WS_WGU);
    bf16raw* WdT = (bf16raw*)(ws + WS_WD); bf16raw* PwT = (bf16raw*)(ws + WS_PW);
    bf16raw* ABUF = (bf16raw*)(ws + WS_A); float* X1 = (float*)(ws + WS_X1);
    bf16raw* PB = (bf16raw*)(ws + WS_P); bf16raw* QN = (bf16raw*)(ws + WS_QN); bf16raw* KALL = (bf16raw*)(ws + WS_KALL); bf16raw* VALL = (bf16raw*)(ws + WS_VALL);
    bf16raw* POOLED = (bf16raw*)(ws + WS_POOL); bf16raw* HB = (bf16raw*)(ws + WS_H);
    const int lo = ap0->ph_lo, hi = ap0->ph_hi;
#ifndef PHMASK
#define PHMASK 0x3ff
#endif
#define IN(k) (((PHMASK >> (k)) & 1) && lo <= (k) && (k) < hi)
#define SEAM(k) do { if (IN(k) && IN((k) + 1)) grid.sync(); } while (0)

    if (IN(0)) {
        PHASE_IDS();
        {
            LAS float* silv = (LAS float*)lds;
            LAS float* red = (LAS float*)(lds + 9 * 512 * 4);
            const float* wada = INP(I_WADA);
            for (int u = bx; u < 192; u += G) {
                const int ks = u / 48, cgp = u % 48;
                for (int i = tid; i < 9 * 512; i += NTHREADS) { const int r = i >> 9, k = i & 511;
                    const float v = (r < 8) ? INP(I_C)[r * DM + ks * 512 + k] : INP(I_CCTX)[ks * 512 + k];
                    silv[i] = v / (1.0f + __expf(-v)); }
                __syncthreads();
                f32x4 acc[9];
#pragma unroll
                for (int r = 0; r < 9; ++r) acc[r] = (f32x4){0.f, 0.f, 0.f, 0.f};
                const float* wp = wada + (size_t)(ks * 512 + wave * 64) * NMOD + cgp * 256 + lane * 4;
                for (int kk = 0; kk < 64; kk += 8) {
                    f32x4 wv[8];
#pragma unroll
                    for (int j = 0; j < 8; ++j) wv[j] = *(const f32x4*)(wp + (size_t)(kk + j) * NMOD);
#pragma unroll
                    for (int r = 0; r < 9; ++r) {
                        const f32x4 s0 = *(const LAS f32x4*)(silv + r * 512 + wave * 64 + kk), s1 = *(const LAS f32x4*)(silv + r * 512 + wave * 64 + kk + 4);
                        acc[r] += s0.x * wv[0]; acc[r] += s0.y * wv[1]; acc[r] += s0.z * wv[2]; acc[r] += s0.w * wv[3];
                        acc[r] += s1.x * wv[4]; acc[r] += s1.y * wv[5]; acc[r] += s1.z * wv[6]; acc[r] += s1.w * wv[7];
                    }
                }
#pragma unroll
                for (int r = 0; r < 9; ++r) *(LAS f32x4*)(red + (wave * 9 + r) * 256 + lane * 4) = acc[r];
                __syncthreads();
                for (int i = tid; i < 9 * 64; i += NTHREADS) { const int r = i >> 6, l = i & 63; f32x4 s = (f32x4){0.f, 0.f, 0.f, 0.f};
#pragma unroll
                    for (int w = 0; w < 8; ++w) s += *(const LAS f32x4*)(red + (w * 9 + r) * 256 + l * 4);
                    *(f32x4*)(MODP + (size_t)(ks * 9 + r) * NMOD + cgp * 256 + l * 4) = s; }
                __syncthreads();
            }
        }
        {
            LAS float* scr = (LAS float*)(lds + wave * 16384);
            constexpr int I_IN = 32 * 80, I_OUT = 32 * 64, I_G = 32 * 176, I_D = 88 * 64, I_P = 4 * 32;
            constexpr int NITEMS = I_IN + I_OUT + 2 * I_G + I_D + I_P;
            for (int it = gw; it < NITEMS; it += NGW) {
                int r = it;
                if (r < I_IN) { const int kb = r / 80, nb = r % 80; transpose_item(INP(I_WIN), DM, PROJ, WinT, kb * 64, nb * 32, nb * 32, scr, lane); continue; } r -= I_IN;
                if (r < I_OUT) { const int kb = r / 64, nb = r % 64; transpose_item(INP(I_WOUT), DM, DM, WoutT, kb * 64, nb * 32, nb * 32, scr, lane); continue; } r -= I_OUT;
                if (r < I_G) { const int kb = r / 176, nb = r % 176, n0 = nb * 32; transpose_item(INP(I_WG), DM, DFF, WguT, kb * 64, n0, (n0 >> 7) * 256 + (n0 & 127), scr, lane); continue; } r -= I_G;
                if (r < I_G) { const int kb = r / 176, nb = r % 176, n0 = nb * 32; transpose_item(INP(I_WU), DM, DFF, WguT, kb * 64, n0, (n0 >> 7) * 256 + 128 + (n0 & 127), scr, lane); continue; } r -= I_G;
                if (r < I_D) { const int kb = r / 64, nb = r % 64; transpose_item(INP(I_WD), DFF, DM, WdT, kb * 64, nb * 32, nb * 32, scr, lane); continue; } r -= I_D;
                { const int g = r / 32, q = r % 32, kb = q / 8, nb = q % 8; transpose_item(INP(I_POOLW) + (size_t)g * 65536, 256, 256, PwT + (size_t)g * 65536, kb * 64, nb * 32, nb * 32, scr, lane); }
            }
        }
    }
    SEAM(0);

    if (IN(1)) {
        PHASE_IDS();
        for (int i = bx * NTHREADS + tid; i < 9 * NMOD; i += G * NTHREADS) { const int col = i % NMOD;
            MODF[i] = INP(I_BADA)[col] + ((MODP[i] + MODP[9 * NMOD + i]) + (MODP[2 * 9 * NMOD + i] + MODP[3 * 9 * NMOD + i])); }
        LAS float* scale = (LAS float*)lds; LAS float* shift = (LAS float*)(lds + DM * 4);
        constexpr int NCH = MT / 8;
        const int c0 = (int)((long)bx * NCH / G), c1 = (int)((long)(bx + 1) * NCH / G);
        int curb = -1;
        for (int ch = c0; ch < c1; ++ch) {
            const int row = ch * 8 + wave; const int b = (row < ML) ? (row >> 11) : 8;
            if (b != curb) { __syncthreads();
                for (int col = tid; col < DM; col += NTHREADS) { float shv = INP(I_BADA)[col], scv = INP(I_BADA)[DM + col];
#pragma unroll
                    for (int ks = 0; ks < 4; ++ks) { shv += MODP[(size_t)(ks * 9 + b) * NMOD + col]; scv += MODP[(size_t)(ks * 9 + b) * NMOD + DM + col]; }
                    scale[col] = INP(I_NMIX)[col] * (1.0f + scv); shift[col] = shv; }
                __syncthreads(); curb = b; }
            const float* src = (row < ML) ? INP(I_X) + (size_t)row * DM : INP(I_CTX) + (size_t)(row - ML) * DM;
            norm_row_bf16(src, ABUF + (size_t)row * DM, scale, shift, lane);
        }
    }
    SEAM(1);

    if (IN(2)) {
        pg8::Gemm g{ABUF, WinT, MT, PROJ, DM, DM, DM, 0}; pg8::StaticOrder S; S.init(MT, PROJ, G, bx);
        pg8::EpiBf16<false> E{PB, PROJ, nullptr};
        pg8::gemm_phase<pg8::EpiBf16<false>, pg8::StaticOrder, true>((LAS unsigned char*)lds, g, S, E);
    }
    SEAM(2);

    if (IN(3)) {
        PHASE_IDS();
        {
            const int sub = lane >> 4, s = lane & 15;
            constexpr long NLAT = (long)ML * 12, NIT = NLAT + (long)MC * 4;
            for (long base = (long)gw * 4; base < NIT; base += (long)NGW * 4) {
                const long idx = base + sub; int row, it;
                if (idx < NLAT) { row = (int)(idx / 12); it = (int)(idx % 12); } else { const long j = idx - NLAT; row = ML + (int)(j >> 2); it = 8 + (int)(j & 3); }
                const u32x4 raw = *(const u32x4*)(PB + (size_t)row * PROJ + 1024 + it * 128 + s * 8);
                const bool lat = row < ML; int b, spos, t = 0;
                if (lat) { b = row >> 11; t = row & 2047; spos = CTXL + t; } else { const int r = row - ML; b = r >> 8; spos = r & 255; }
                float v[8] = {bflo(raw.x), bfhi(raw.x), bflo(raw.y), bfhi(raw.y), bflo(raw.z), bfhi(raw.z), bflo(raw.w), bfhi(raw.w)};
                float ss = 0.f;
#pragma unroll
                for (int i = 0; i < 8; ++i) ss += v[i] * v[i];
                ss += __shfl_xor(ss, 1); ss += __shfl_xor(ss, 2); ss += __shfl_xor(ss, 4); ss += __shfl_xor(ss, 8);
                const float rstd = 1.0f / sqrtf(ss * (1.f / 128.f) + EPS);
                const float* gn = (it < 8 ? INP(I_QN) : INP(I_KN)) + s * 8;
                const f32x4 g0 = *(const f32x4*)gn, g1 = *(const f32x4*)(gn + 4);
                float y[8] = {v[0] * rstd * g0.x, v[1] * rstd * g0.y, v[2] * rstd * g0.z, v[3] * rstd * g0.w, v[4] * rstd * g1.x, v[5] * rstd * g1.y, v[6] * rstd * g1.z, v[7] * rstd * g1.w};
                if (lat) {
#pragma unroll
                    for (int p = 0; p < 4; ++p) { const int i = s * 4 + p, j = i & 31; const float pos = (float)((i < 32) ? (t >> 6) : (t & 63));
                        const float freq = __builtin_amdgcn_exp2f(-(float)(2 * j) * (13.287712379549449f / 64.f));
                        const float rev = (pos * freq) * 0.15915494309189535f;
                        const float cs = __builtin_amdgcn_cosf(rev), sn = __builtin_amdgcn_sinf(rev);
                        const float x1 = y[2 * p], x2 = y[2 * p + 1]; y[2 * p] = x1 * cs - x2 * sn; y[2 * p + 1] = x1 * sn + x2 * cs; }
                }
                u32x4 w; w.x = pk2(y[0], y[1]); w.y = pk2(y[2], y[3]); w.z = pk2(y[4], y[5]); w.w = pk2(y[6], y[7]);
                if (it < 8) *(u32x4*)(QN + (size_t)row * 1024 + it * 128 + s * 8) = w;
                else if (it < 10) *(u32x4*)(KALL + ((size_t)b * SKV + spos) * 256 + (it - 8) * 128 + s * 8) = w;
                else *(u32x4*)(VALL + ((size_t)b * SKV + spos) * 256 + (it - 10) * 128 + s * 8) = raw;
            }
        }
        {
            const long nth = (long)G * NTHREADS;
            for (long i = (long)vcu * NTHREADS + tid; i < (long)ML * 128; i += nth) {
                const int row = (int)(i >> 7), ch = (int)(i & 127), gidx = ch >> 5, half = 1 << gidx, t = row & 2047;
                const int tlo = (t - half < 0) ? 0 : t - half, thi = (t + half > SEQ) ? SEQ : t + half;
                const bf16raw* pbase = PB + (size_t)(row - t) * PROJ + ch * 8;
                float acc[8] = {0.f, 0.f, 0.f, 0.f, 0.f, 0.f, 0.f, 0.f};
                for (int tt = tlo; tt < thi; ++tt) { const u32x4 r = *(const u32x4*)(pbase + (size_t)tt * PROJ);
                    acc[0] += bflo(r.x); acc[1] += bfhi(r.x); acc[2] += bflo(r.y); acc[3] += bfhi(r.y); acc[4] += bflo(r.z); acc[5] += bfhi(r.z); acc[6] += bflo(r.w); acc[7] += bfhi(r.w); }
                const u32x4 me = *(const u32x4*)(pbase + (size_t)t * PROJ); const float inv = 1.0f / (float)(thi - tlo);
                u32x4 w; w.x = pk2(acc[0] * inv - bflo(me.x), acc[1] * inv - bfhi(me.x)); w.y = pk2(acc[2] * inv - bflo(me.y), acc[3] * inv - bfhi(me.y));
                w.z = pk2(acc[4] * inv - bflo(me.z), acc[5] * inv - bfhi(me.z)); w.w = pk2(acc[6] * inv - bflo(me.w), acc[7] * inv - bfhi(me.w));
                *(u32x4*)(POOLED + (size_t)row * 1024 + ch * 8) = w;
            }
        }
    }
    SEAM(3);

    if (IN(4)) {
#ifndef NO_ATT
        for (int unit = vcu; unit < 512; unit += G) {
            const int pair = unit >> 5, b = pair >> 1, kvh = pair & 1, r = unit & 31, gq = r >> 3, qb = r & 7, h = kvh * 4 + gq;
            att::attn_dense_body((const att::bf16*)(QN + ((size_t)b * SEQ + qb * 256) * 1024 + h * 128),
                                 (const att::bf16*)(KALL + (size_t)b * SKV * 256 + kvh * 128), (const att::bf16*)(VALL + (size_t)b * SKV * 256 + kvh * 128),
                                 ABUF + ((size_t)b * SEQ + qb * 256) * 2048 + 1024 + h * 128, SKV, (char*)lds);
            __syncthreads();
        }
#endif
#ifndef NO_POOLG
        {
        pg8::Gemm g{POOLED, PwT, ML, 1024, 256, 1024, 256, 256}; pg8::StaticOrder S; S.init(ML, 1024, G, bx);
        pg8::EpiBf16<true> E{ABUF, 2048, INP(I_POOLS)};
        pg8::gemm_phase<pg8::EpiBf16<true>, pg8::StaticOrder, true>((LAS unsigned char*)lds, g, S, E);
        }
#endif
    }
    SEAM(4);

    if (IN(5)) {
        pg8::Gemm g{ABUF, WoutT, ML, DM, DM, DM, DM, 0}; pg8::StaticOrder S; S.init(ML, DM, G, bx);
        pg8::EpiRes E{INP(I_X), X1, MODF + 2 * DM};
        pg8::gemm_phase<pg8::EpiRes, pg8::StaticOrder, true>((LAS unsigned char*)lds, g, S, E);
    }
    SEAM(5);

    if (IN(6)) {
        PHASE_IDS();
        LAS float* scale = (LAS float*)lds; LAS float* shift = (LAS float*)(lds + DM * 4);
        constexpr int NCH = ML / 8;
        const int c0 = (int)((long)bx * NCH / G), c1 = (int)((long)(bx + 1) * NCH / G);
        int curb = -1;
        for (int ch = c0; ch < c1; ++ch) {
            const int row = ch * 8 + wave; const int b = row >> 11;
            if (b != curb) { __syncthreads();
                for (int col = tid; col < DM; col += NTHREADS) { scale[col] = INP(I_NFFN)[col] * (1.0f + MODF[(size_t)b * NMOD + 4 * DM + col]); shift[col] = MODF[(size_t)b * NMOD + 3 * DM + col]; }
                __syncthreads(); curb = b; }
            norm_row_bf16(X1 + (size_t)row * DM, ABUF + (size_t)row * DM, scale, shift, lane);
        }
    }
    SEAM(6);

    if (IN(7)) {
        pg8::Gemm g{ABUF, WguT, ML, 2 * DFF, DM, DM, DM, 0}; pg8::StaticOrder S; S.init(ML, 2 * DFF, G, bx);
        pg8::EpiSwiGLU E{HB, DFF};
        pg8::gemm_phase<pg8::EpiSwiGLU, pg8::StaticOrder, true>((LAS unsigned char*)lds, g, S, E);
    }
    SEAM(7);

    if (IN(8)) {
        pg8::Gemm g{HB, WdT, ML, DM, DFF, DFF, DFF, 0}; pg8::StaticOrder S; S.init(ML, DM, G, bx);
        pg8::EpiRes E{X1, X1, MODF + 5 * DM};
        pg8::gemm_phase<pg8::EpiRes, pg8::StaticOrder, true>((LAS unsigned char*)lds, g, S, E);
    }
    SEAM(8);

    if (IN(9)) {
        PHASE_IDS();
        const float* fn = INP(I_FN);
        for (int row = gw; row < ML; row += NGW) {
            const f32x4* xr = (const f32x4*)(X1 + (size_t)row * DM) + lane;
            f32x4 v[8]; float s = 0.f;
#pragma unroll
            for (int j = 0; j < 8; ++j) { v[j] = xr[64 * j]; s += (v[j].x * v[j].x + v[j].y * v[j].y) + (v[j].z * v[j].z + v[j].w * v[j].w); }
            const float rstd = 1.0f / sqrtf(wave_sum(s) * (1.f / DM) + EPS);
            f32x4* orow = (f32x4*)(ARGP()->out + (size_t)row * DM) + lane;
#pragma unroll
            for (int j = 0; j < 8; ++j) orow[64 * j] = v[j] * rstd * *((const f32x4*)fn + lane + 64 * j);
        }
    }
#undef IN
#undef SEAM
}

extern "C" void kernel_launch(void* const* d_in, const int* in_sizes, int n_in, void* d_out, int out_size, void* d_ws, size_t ws_size, hipStream_t stream) {
    static int grid = 0;
    if (grid == 0) {
        if (n_in != 18 || in_sizes[0] != ML * DM || out_size != ML * DM || ws_size < WS_END) {
            fprintf(stderr, "kernel_launch: shape mismatch: n_in %d in0 %d out %d ws %zu (need >= %zu)\n", n_in, n_in > 0 ? in_sizes[0] : -1, out_size, ws_size, (size_t)WS_END); grid = -1; return; }
        int dev = 0, cus = 0, per_cu = 0;
        if (hipGetDevice(&dev) != hipSuccess || hipDeviceGetAttribute(&cus, hipDeviceAttributeMultiprocessorCount, dev) != hipSuccess) { fprintf(stderr, "kernel_launch: device query failed\n"); grid = -1; return; }
        if (hipFuncSetAttribute((const void*)fwd_megakernel, hipFuncAttributeMaxDynamicSharedMemorySize, LDS_BYTES) != hipSuccess) { fprintf(stderr, "kernel_launch: hipFuncSetAttribute failed\n"); grid = -1; return; }
        if (hipOccupancyMaxActiveBlocksPerMultiprocessor(&per_cu, (const void*)fwd_megakernel, NTHREADS, LDS_BYTES) != hipSuccess || per_cu < 1) {
            fprintf(stderr, "kernel_launch: occupancy query reports %d blocks per CU\n", per_cu); (void)hipGetLastError(); per_cu = 1; }
        grid = cus * 1;
        fprintf(stderr, "kernel_launch: cus %d per_cu %d grid %d\n", cus, per_cu, grid);
    }
    if (grid < 0) return;
    Args a{};
    for (int i = 0; i < 18; ++i) a.in[i] = (const float*)d_in[i];
    a.out = (float*)d_out; a.ws = (unsigned char*)d_ws;
#if MK_MULTI
    for (int ph = 0; ph < 10; ++ph) { a.ph_lo = ph; a.ph_hi = ph + 1; hipLaunchKernelGGL(fwd_megakernel, dim3(grid), dim3(NTHREADS), LDS_BYTES, stream, a); }
#else
    a.ph_lo = 0; a.ph_hi = 10;
    void* args[] = {&a};
    hipError_t e = hipLaunchCooperativeKernel((void*)fwd_megakernel, dim3(grid), dim3(NTHREADS), args, LDS_BYTES, stream);
    if (e != hipSuccess) fprintf(stderr, "kernel_launch: cooperative launch failed: %s (grid %d)\n", hipGetErrorString(e), grid);
#endif
}
```

```cpp
#include <hip/hip_runtime.h>
#include <hip/hip_bf16.h>
#include <hip/hip_cooperative_groups.h>
#include <cstdio>
#include <cstdint>
namespace cg = cooperative_groups;

#ifndef MK_MULTI
#define MK_MULTI 0
#endif

__device__ __forceinline__ int opaque_tid() { int t = threadIdx.x; asm volatile("" : "+v"(t)); return t; }

namespace pg8 {
#define PG8_LAS __attribute__((address_space(3)))
typedef unsigned short bf16_t;
typedef short bf16x8 __attribute__((ext_vector_type(8)));
typedef float f32x4 __attribute__((ext_vector_type(4)));
typedef unsigned u32x4 __attribute__((ext_vector_type(4)));
constexpr int BM = 256, BK = 64, HALF = 128, HTB = HALF * BK * 2, STAGE_BYTES = 8 * HTB, NXCD = 8, WGM = 8;

__host__ __device__ __forceinline__ int lds_byte(int r, int c) { const int st = (r >> 4) * 2 + (c >> 5), rr = r & 15, cc = c & 31, ob = rr * 64 + cc * 2; return st * 1024 + (ob ^ (((ob >> 9) & 1) << 5)); }
__host__ __device__ __forceinline__ void stage_rc(int b, int& R, int& C) { const int st = b / 1024, sb = b % 1024, swz = sb ^ (((sb >> 9) & 1) << 5); R = (st >> 1) * 16 + swz / 64; C = (st & 1) * 32 + (swz % 64) / 2; }
__host__ __device__ __forceinline__ int perm32(int rho) { const int n = rho >> 4, i = rho & 15; return 8 * (i >> 2) + 4 * n + (i & 3); }

struct Unit { int pm, pn; };
struct Gemm { const bf16_t* A; const bf16_t* Bt; int M, N, K, lda, ldb, a_pn_off; };

struct StaticOrder {
    int nM, nN, nwg, G, c;
    __host__ __device__ void init(int M, int N, int G_, int c_) { nM = M / BM; nN = N / BM; nwg = nM * nN; G = G_; c = c_; }
    __host__ __device__ bool next(int i, Unit& u) const {
        const long L = (long)i * G + c; if (L >= nwg) return false;
        int wgid = (int)L; { const int q = nwg / NXCD, r = nwg % NXCD, xcd = wgid % NXCD, off = wgid / NXCD; wgid = (xcd < r ? xcd * (q + 1) : r * (q + 1) + (xcd - r) * q) + off; }
        const int nig = WGM * nN, gid = wgid / nig, fm = gid * WGM, gsz = (nM - fm) < WGM ? (nM - fm) : WGM;
        u.pm = fm + ((wgid % nig) % gsz); u.pn = (wgid % nig) / gsz; return true;
    }
};

__device__ __forceinline__ unsigned cvt_pk_bf16(float lo, float hi) { unsigned r; asm volatile("v_cvt_pk_bf16_f32 %0, %1, %2" : "=v"(r) : "v"(lo), "v"(hi)); return r; }


template <bool HAS_SCALE> struct EpiBf16 {
    static constexpr bool PERM = true;
    bf16_t* O; int ldc; const float* colscale;
    __device__ __forceinline__ void operator()(const f32x4 (&acc)[2][2][4][2], const Unit& u, int wr, int wc, int fr, int fq) const {
        const int row0 = u.pm * BM + wr * 64 + fr; const int col0 = u.pn * BM + wc * 32 + 8 * fq;
#pragma unroll
        for (int bj = 0; bj < 2; ++bj) {
            f32x4 s0 = (f32x4){1.f, 1.f, 1.f, 1.f}, s1 = s0;
            if constexpr (HAS_SCALE) { s0 = *(const f32x4*)(colscale + col0 + bj * HALF); s1 = *(const f32x4*)(colscale + col0 + bj * HALF + 4); }
#pragma unroll
            for (int ai = 0; ai < 2; ++ai)
#pragma unroll
                for (int m = 0; m < 4; ++m) { bf16_t* rowp = O + (size_t)(row0 + ai * HALF + m * 16) * ldc + col0 + bj * HALF;
                    f32x4 v0 = acc[ai][bj][m][0], v1 = acc[ai][bj][m][1];
                    if constexpr (HAS_SCALE) { v0 = v0 * s0; v1 = v1 * s1; }
                    u32x4 w; w.x = cvt_pk_bf16(v0[0], v0[1]); w.y = cvt_pk_bf16(v0[2], v0[3]); w.z = cvt_pk_bf16(v1[0], v1[1]); w.w = cvt_pk_bf16(v1[2], v1[3]);
                    *(u32x4*)rowp = w; }
        }
    }
};
struct EpiSwiGLU {
    static constexpr bool PERM = true;
    bf16_t* H; int ldc;
    __device__ __forceinline__ void operator()(const f32x4 (&acc)[2][2][4][2], const Unit& u, int wr, int wc, int fr, int fq) const {
        const int row0 = u.pm * BM + wr * 64 + fr; const int col0 = u.pn * HALF + wc * 32 + 8 * fq;
#pragma unroll
        for (int ai = 0; ai < 2; ++ai)
#pragma unroll
            for (int m = 0; m < 4; ++m) { bf16_t* rowp = H + (size_t)(row0 + ai * HALF + m * 16) * ldc + col0; float hv[8];
#pragma unroll
                for (int n = 0; n < 2; ++n)
#pragma unroll
                    for (int e = 0; e < 4; ++e) { const float g = acc[ai][0][m][n][e], up = acc[ai][1][m][n][e];
                        const float sg = g * __builtin_amdgcn_rcpf(1.0f + __builtin_amdgcn_exp2f(-1.4426950408889634f * g)); hv[n * 4 + e] = sg * up; }
                u32x4 w; w.x = cvt_pk_bf16(hv[0], hv[1]); w.y = cvt_pk_bf16(hv[2], hv[3]); w.z = cvt_pk_bf16(hv[4], hv[5]); w.w = cvt_pk_bf16(hv[6], hv[7]);
                *(u32x4*)rowp = w; }
    }
};
struct EpiRes {
    static constexpr bool PERM = true;
    const float* base; float* out; const float* gate;
    __device__ __forceinline__ void operator()(const f32x4 (&acc)[2][2][4][2], const Unit& u, int wr, int wc, int fr, int fq) const {
        const int row0 = u.pm * BM + wr * 64 + fr; const int col0 = u.pn * BM + wc * 32 + 8 * fq;
        const float* gp = gate + (size_t)(u.pm >> 3) * 12288 + col0;
        f32x4 gv[2][2];
#pragma unroll
        for (int bj = 0; bj < 2; ++bj)
#pragma unroll
            for (int n = 0; n < 2; ++n) gv[bj][n] = *(const f32x4*)(gp + bj * HALF + 4 * n);
#pragma unroll
        for (int ai = 0; ai < 2; ++ai)
#pragma unroll
            for (int m = 0; m < 4; ++m) { const size_t off = (size_t)(row0 + ai * HALF + m * 16) * 2048 + col0;
#pragma unroll
                for (int bj = 0; bj < 2; ++bj)
#pragma unroll
                    for (int n = 0; n < 2; ++n) { const f32x4 x = *(const f32x4*)(base + off + bj * HALF + 4 * n);
                        *(f32x4*)(out + off + bj * HALF + 4 * n) = x + gv[bj][n] * acc[ai][bj][m][n]; } }
    }
};

template <class Epi, class Sched, bool ALIGN_EPI>
__device__ __forceinline__ void gemm_phase(PG8_LAS unsigned char* lds, const Gemm g, const Sched& S, const Epi& E) {
    const int tid = opaque_tid(), wid = __builtin_amdgcn_readfirstlane(tid >> 6), lane = tid & 63, wr = wid >> 2, wc = wid & 3, fr = lane & 15, fq = lane >> 4;
    const int K = g.K, nt = K / BK;
    unsigned voffA[2], voffB[2];
#pragma unroll
    for (int i = 0; i < 2; ++i) { int R, C; stage_rc(tid * 16 + i * 8192, R, C); const int Rb = Epi::PERM ? ((R & ~31) + perm32(R & 31)) : R;
        voffA[i] = (unsigned)(R * g.lda + C) * 2u; voffB[i] = (unsigned)(Rb * g.ldb + C) * 2u; }
    const size_t kstep = (size_t)(BK * 2);
    const size_t hstepA = (size_t)HALF * g.lda * 2, hstepB = (size_t)HALF * g.ldb * 2;
    const size_t tstepA = 2 * hstepA, tstepB = 2 * hstepB, pnoffA = (size_t)g.a_pn_off * 2;
    const unsigned ldsw = (unsigned)wid * 1024u;
    const int aoff = lds_byte(wr * 64 + fr, fq * 8), boff = lds_byte(wc * 32 + fr, fq * 8);
#define PG8_SA(b, h) (((b) * 2 + (h)) * HTB)
#define PG8_SB(b, h) ((4 + (b) * 2 + (h)) * HTB)
#define PG8_STAGE(bufoff, gbase, voff) do { _Pragma("unroll") for (int _i = 0; _i < 2; ++_i) \
        __builtin_amdgcn_global_load_lds((const unsigned*)((const char*)(gbase) + (voff)[_i]), (PG8_LAS unsigned*)(lds + (bufoff) + ldsw + _i * 8192), 16, 0, 0); } while (0)
#define PG8_LDA(dst, b, h) do { _Pragma("unroll") for (int m = 0; m < 4; ++m) _Pragma("unroll") for (int k = 0; k < 2; ++k) dst[m][k] = *(const PG8_LAS bf16x8*)(lds + PG8_SA(b, h) + aoff + m * 2048 + k * 1024); } while (0)
#define PG8_LDB(dst, b, h) do { _Pragma("unroll") for (int n = 0; n < 2; ++n) _Pragma("unroll") for (int k = 0; k < 2; ++k) dst[n][k] = *(const PG8_LAS bf16x8*)(lds + PG8_SB(b, h) + boff + n * 2048 + k * 1024); } while (0)
#define PG8_MMA(ai, bj, At, Bt) do { __builtin_amdgcn_s_setprio(1); _Pragma("unroll") for (int m = 0; m < 4; ++m) _Pragma("unroll") for (int n = 0; n < 2; ++n) _Pragma("unroll") for (int k = 0; k < 2; ++k) \
        acc[ai][bj][m][n] = __builtin_amdgcn_mfma_f32_16x16x32_bf16(Bt[n][k], At[m][k], acc[ai][bj][m][n], 0, 0, 0); __builtin_amdgcn_s_setprio(0); } while (0)
#define PG8_WAIT_V(n) asm volatile("s_waitcnt vmcnt(" #n ")" ::: "memory")
#define PG8_WAIT_L(n) asm volatile("s_waitcnt lgkmcnt(" #n ")" ::: "memory")
#define PG8_BAR __builtin_amdgcn_s_barrier()
#define PG8_SCHED __builtin_amdgcn_sched_barrier(0)
    Unit cur, nxt; int ui = 0;
    if (!S.next(0, cur)) return;
    f32x4 acc[2][2][4][2];
#pragma unroll
    for (int a = 0; a < 2; ++a)
#pragma unroll
        for (int b = 0; b < 2; ++b)
#pragma unroll
            for (int m = 0; m < 4; ++m)
#pragma unroll
                for (int n = 0; n < 2; ++n) acc[a][b][m][n] = (f32x4){0.f, 0.f, 0.f, 0.f};
    bf16x8 At[4][2], B0[2][2], B1[2][2];
    const char* cA = (const char*)g.A + (size_t)cur.pm * tstepA + (size_t)cur.pn * pnoffA; const char* cB = (const char*)g.Bt + (size_t)cur.pn * tstepB;
    PG8_STAGE(PG8_SB(0, 0), cB, voffB); PG8_STAGE(PG8_SB(0, 1), cB + hstepB, voffB); PG8_STAGE(PG8_SA(0, 0), cA, voffA); PG8_STAGE(PG8_SA(0, 1), cA + hstepA, voffA);
    if (wr == 1) PG8_BAR;
    PG8_WAIT_V(2); PG8_BAR;
    PG8_STAGE(PG8_SB(1, 0), cB + kstep, voffB); PG8_STAGE(PG8_SA(1, 0), cA + kstep, voffA); PG8_STAGE(PG8_SB(1, 1), cB + hstepB + kstep, voffB);
    PG8_WAIT_V(6); PG8_BAR;
    for (;;) {
        const bool has_next = S.next(ui + 1, nxt);
        const char* nA = has_next ? (const char*)g.A + (size_t)nxt.pm * tstepA + (size_t)nxt.pn * pnoffA : cA; const char* nB = has_next ? (const char*)g.Bt + (size_t)nxt.pn * tstepB : cB;
#pragma unroll 1
        for (int t = 0; t < nt; t += 2) {
            const bool last = (t == nt - 2);
            const char* a1 = cA + (size_t)(t + 1) * kstep;
            const char* a2 = last ? nA : cA + (size_t)(t + 2) * kstep; const char* b2 = last ? nB : cB + (size_t)(t + 2) * kstep;
            const char* a3 = a2 + kstep; const char* b3 = b2 + kstep;
            PG8_LDB(B0, 0, 0); PG8_LDB(B1, 0, 1); PG8_SCHED; PG8_LDA(At, 0, 0); PG8_STAGE(PG8_SA(1, 1), a1 + hstepA, voffA);
            PG8_WAIT_V(8); PG8_WAIT_L(0); PG8_BAR; PG8_MMA(0, 0, At, B0); PG8_MMA(0, 1, At, B1); PG8_BAR; PG8_SCHED;
            PG8_LDA(At, 0, 1); PG8_STAGE(PG8_SB(0, 0), b2, voffB); PG8_STAGE(PG8_SB(0, 1), b2 + hstepB, voffB); PG8_STAGE(PG8_SA(0, 0), a2, voffA);
            PG8_WAIT_V(8); PG8_WAIT_L(0); PG8_BAR; PG8_MMA(1, 0, At, B0); PG8_MMA(1, 1, At, B1); PG8_BAR; PG8_SCHED;
            PG8_LDB(B0, 1, 0); PG8_LDB(B1, 1, 1); PG8_SCHED; PG8_LDA(At, 1, 0); PG8_STAGE(PG8_SA(0, 1), a2 + hstepA, voffA);
            PG8_WAIT_V(8); PG8_WAIT_L(0); PG8_BAR; PG8_MMA(0, 0, At, B0); PG8_MMA(0, 1, At, B1); PG8_BAR; PG8_SCHED;
            PG8_LDA(At, 1, 1); PG8_STAGE(PG8_SB(1, 0), b3, voffB); PG8_STAGE(PG8_SB(1, 1), b3 + hstepB, voffB); PG8_STAGE(PG8_SA(1, 0), a3, voffA);
            PG8_WAIT_V(8); PG8_WAIT_L(0); PG8_BAR; PG8_MMA(1, 0, At, B0); PG8_MMA(1, 1, At, B1); PG8_BAR; PG8_SCHED;
        }
        if constexpr (ALIGN_EPI) { if (wr == 0) PG8_BAR; }
        E(acc, cur, wr, wc, fr, fq);
        if (!has_next) break;
#pragma unroll
        for (int a = 0; a < 2; ++a)
#pragma unroll
            for (int b = 0; b < 2; ++b)
#pragma unroll
                for (int m = 0; m < 4; ++m)
#pragma unroll
                    for (int n = 0; n < 2; ++n) acc[a][b][m][n] = (f32x4){0.f, 0.f, 0.f, 0.f};
        cur = nxt; cA = nA; cB = nB; ++ui;
        if constexpr (ALIGN_EPI) { if (wr == 1) PG8_BAR; }
    }
    PG8_WAIT_V(0);
    if constexpr (!ALIGN_EPI) { if (wr == 0) PG8_BAR; }
    PG8_BAR;
#undef PG8_SA
#undef PG8_SB
#undef PG8_STAGE
#undef PG8_LDA
#undef PG8_LDB
#undef PG8_MMA
#undef PG8_WAIT_V
#undef PG8_WAIT_L
#undef PG8_BAR
#undef PG8_SCHED
}
}

namespace att {
using bf16 = __hip_bfloat16;
constexpr int D = 128, NW = 8, QBLK = 32, KVBLK = 64;
constexpr float SCALE = 0.088388347648318440f;
constexpr float THR = 8.f;
constexpr int SDEPTH = 2;
constexpr int LDQ = 1024, LDK = 256, LDO = 2048;
constexpr size_t SHM_V = KVBLK * D * 2, SHM_K = KVBLK * D * 2, SHM_ATTN = 2 * SHM_V + 2 * SHM_K + NW * 64 * 4;
using bf16x8 = __attribute__((ext_vector_type(8))) short;
using s16x4  = __attribute__((ext_vector_type(4))) short;
using f32x16 = __attribute__((ext_vector_type(16))) float;
using u32x4  = __attribute__((ext_vector_type(4))) unsigned;
#define KSWZ(row, colB) ((row) * 256 + ((colB) ^ (((row) & 7) << 4)))
#define SBAR() __builtin_amdgcn_sched_barrier(0)
__device__ __forceinline__ int crow(int r, int hi) { return (r & 3) + 8 * (r >> 2) + 4 * hi; }
__device__ __forceinline__ unsigned cvtpk(float lo, float hi) { unsigned r; asm volatile("v_cvt_pk_bf16_f32 %0, %1, %2" : "=v"(r) : "v"(lo), "v"(hi)); return r; }
__device__ __forceinline__ bf16x8 ld8(const bf16* p) { return *reinterpret_cast<const bf16x8*>(p); }

__device__ __forceinline__ void partialSM(f32x16& p0, f32x16& p1, float& m_reg, float& mn, float& alpha) {
  constexpr float C = SCALE * 1.4426950408889634f;
  float pmax = p0[0]; for (int r = 1; r < 16; ++r) pmax = fmaxf(pmax, p0[r]); for (int r = 0; r < 16; ++r) pmax = fmaxf(pmax, p1[r]);
  { auto rr = __builtin_amdgcn_permlane32_swap(__float_as_uint(pmax), __float_as_uint(pmax), false, false);
    pmax = fmaxf(__uint_as_float(rr[0]), __uint_as_float(rr[1])); }
  if (__builtin_expect(__all(pmax - m_reg <= THR / SCALE), 1)) { mn = m_reg; alpha = 1.f; }
  else { mn = fmaxf(m_reg, pmax); alpha = __builtin_amdgcn_exp2f((m_reg - mn) * C); m_reg = mn; }
  float mnC = -mn * C;
  for (int r = 0; r < 16; ++r) p0[r] = fmaf(p0[r], C, mnC); for (int r = 0; r < 16; ++r) p1[r] = fmaf(p1[r], C, mnC);
  for (int r = 0; r < 16; ++r) p0[r] = __builtin_amdgcn_exp2f(p0[r]);
}
__device__ __forceinline__ void finishSM(f32x16& p0, f32x16& p1, float alpha, float& l_reg, bf16x8& pa0, bf16x8& pa1, bf16x8& pa2, bf16x8& pa3) {
  for (int r = 0; r < 16; ++r) p1[r] = __builtin_amdgcn_exp2f(p1[r]);
  float ps = 0; for (int r = 0; r < 16; ++r) ps += p0[r]; for (int r = 0; r < 16; ++r) ps += p1[r];
  { auto rr = __builtin_amdgcn_permlane32_swap(__float_as_uint(ps), __float_as_uint(ps), false, false);
    ps = __uint_as_float(rr[0]) + __uint_as_float(rr[1]); }
  l_reg = l_reg * alpha + ps;
#define PK4(P, BASE, OUT) do { unsigned a0 = cvtpk(P[BASE + 0], P[BASE + 1]), a1 = cvtpk(P[BASE + 2], P[BASE + 3]);   \
    unsigned b0 = cvtpk(P[BASE + 4], P[BASE + 5]), b1 = cvtpk(P[BASE + 6], P[BASE + 7]);                              \
    auto r0 = __builtin_amdgcn_permlane32_swap(a0, b0, false, false); auto r1 = __builtin_amdgcn_permlane32_swap(a1, b1, false, false); \
    u32x4 w = {r0[0], r1[0], r0[1], r1[1]}; OUT = *reinterpret_cast<bf16x8*>(&w); } while (0)
  PK4(p0, 0, pa0); PK4(p0, 8, pa1); PK4(p1, 0, pa2); PK4(p1, 8, pa3);
#undef PK4
}
__device__ __forceinline__ void qkt(f32x16& p0, f32x16& p1, const bf16* Ks, const bf16x8* qr, int r32, int hi) {
  p0 = f32x16{}; p1 = f32x16{};
  for (int d0 = 0; d0 < 8; ++d0) { int cb = (d0 * 16 + hi * 8) * 2;
    bf16x8 b0 = *reinterpret_cast<const bf16x8*>((const char*)Ks + KSWZ(r32, cb));
    bf16x8 b1 = *reinterpret_cast<const bf16x8*>((const char*)Ks + KSWZ(32 + r32, cb));
    p0 = __builtin_amdgcn_mfma_f32_32x32x16_bf16(b0, qr[d0], p0, 0, 0, 0);
    p1 = __builtin_amdgcn_mfma_f32_32x32x16_bf16(b1, qr[d0], p1, 0, 0, 0); }
}
__device__ __forceinline__ int v_st(int k, int c) { const int kk = (k & ~0xC) | ((k & 4) << 1) | ((k & 8) >> 1); return ((kk >> 3) * 4 + (c >> 5)) * 512 + ((kk & 7) * 32 + (c & 31)) * 2; }
__device__ __forceinline__ int v_rd_base(int lane) { return ((lane & 3) << 3) | (((lane >> 2) & 3) << 6) | (((lane >> 4) & 1) << 5) | (((lane >> 5) & 1) << 8); }
constexpr int v_rd_off(int d0, int ks, int half) { return d0 * 512 + ks * 4096 + half * 2048; }
template <int OFF> __device__ __forceinline__ s16x4 tr_read(int vb) {
  s16x4 r; asm volatile("ds_read_b64_tr_b16 %0, %1 offset:%2" : "=&v"(r) : "v"(vb), "i"(OFF) : "memory"); return r;
}
template <int D0> __device__ __forceinline__ void pv_one(f32x16& od, int vb, bf16x8 pa0, bf16x8 pa1, bf16x8 pa2, bf16x8 pa3) {
  const s16x4 l0 = tr_read<v_rd_off(D0, 0, 0)>(vb), h0 = tr_read<v_rd_off(D0, 0, 1)>(vb), l1 = tr_read<v_rd_off(D0, 1, 0)>(vb), h1 = tr_read<v_rd_off(D0, 1, 1)>(vb);
  const s16x4 l2 = tr_read<v_rd_off(D0, 2, 0)>(vb), h2 = tr_read<v_rd_off(D0, 2, 1)>(vb), l3 = tr_read<v_rd_off(D0, 3, 0)>(vb), h3 = tr_read<v_rd_off(D0, 3, 1)>(vb);
  asm volatile("s_waitcnt lgkmcnt(0)" ::: "memory"); SBAR();
#define PK(L, H) (bf16x8){L[0], L[1], L[2], L[3], H[0], H[1], H[2], H[3]}
  od = __builtin_amdgcn_mfma_f32_32x32x16_bf16(pa0, PK(l0, h0), od, 0, 0, 0);
  od = __builtin_amdgcn_mfma_f32_32x32x16_bf16(pa1, PK(l1, h1), od, 0, 0, 0);
  od = __builtin_amdgcn_mfma_f32_32x32x16_bf16(pa2, PK(l2, h2), od, 0, 0, 0);
  od = __builtin_amdgcn_mfma_f32_32x32x16_bf16(pa3, PK(l3, h3), od, 0, 0, 0);
#undef PK
}
__device__ __forceinline__ void pv_d0(f32x16* o, int vb, bf16x8 pa0, bf16x8 pa1, bf16x8 pa2, bf16x8 pa3) {
  pv_one<0>(o[0], vb, pa0, pa1, pa2, pa3); pv_one<1>(o[1], vb, pa0, pa1, pa2, pa3); pv_one<2>(o[2], vb, pa0, pa1, pa2, pa3); pv_one<3>(o[3], vb, pa0, pa1, pa2, pa3);
}
__device__ __forceinline__ void attn_dense_body(const bf16* __restrict__ Qb, const bf16* __restrict__ Kh, const bf16* __restrict__ Vh,
                                                unsigned short* __restrict__ Ob, int seq, char* lds) {
  const int tid = opaque_tid(), wid = tid >> 6, lane = tid & 63, r32 = lane & 31, hi = lane >> 5;
  bf16* V_lds = (bf16*)lds; bf16* K_lds = (bf16*)(lds + 2 * SHM_V);
  float* ws = (float*)(lds + 2 * SHM_V + 2 * SHM_K) + wid * 64; float* li_l = ws; float* al_l = ws + 32;
  float m_reg = -1e30f, l_reg = 0; f32x16 o[4] = {}; bf16x8 qr[8];
  const bf16* Qw = Qb + (long)(wid * QBLK + r32) * LDQ + hi * 8;
#pragma unroll
  for (int d0 = 0; d0 < 8; ++d0) qr[d0] = ld8(Qw + d0 * 16);
  const int sr = tid >> 4, sc = (tid & 15) * 8, vst0 = v_st(sr, sc), vst1 = v_st(32 + sr, sc);
  const int vb0 = (int)(uintptr_t)V_lds + v_rd_base(lane);
  struct { bf16x8 vs0, vs1, ks0, ks1; } sr_[SDEPTH];
  const unsigned goff0 = (unsigned)(sr * LDK + sc) * 2u, goff1 = goff0 + 32u * LDK * 2u;
#define SLOAD(i, k0) do { const char* vt_ = (const char*)Vh + (size_t)(k0) * (LDK * 2); const char* kt_ = (const char*)Kh + (size_t)(k0) * (LDK * 2); \
    sr_[i].vs0 = *(const bf16x8*)(vt_ + goff0); sr_[i].vs1 = *(const bf16x8*)(vt_ + goff1); \
    sr_[i].ks0 = *(const bf16x8*)(kt_ + goff0); sr_[i].ks1 = *(const bf16x8*)(kt_ + goff1); } while (0)
#define SWRITE(b, i) do { *(bf16x8*)((char*)V_lds + (b) * SHM_V + vst0) = sr_[i].vs0;          \
    *(bf16x8*)((char*)V_lds + (b) * SHM_V + vst1) = sr_[i].vs1; int kc = sc * 2;               \
    *(bf16x8*)((char*)K_lds + (b) * SHM_K + KSWZ(sr, kc)) = sr_[i].ks0;                       \
    *(bf16x8*)((char*)K_lds + (b) * SHM_K + KSWZ(32 + sr, kc)) = sr_[i].ks1; } while (0)
#define SWAIT() do { asm volatile("s_waitcnt vmcnt(4)" ::: "memory"); } while (0)
#define RESC(a) do { if (__any((a) < 1.f)) { if (hi == 0) al_l[r32] = (a); asm volatile("s_waitcnt lgkmcnt(0)" ::: "memory"); \
    for (int d = 0; d < 4; ++d) for (int r = 0; r < 16; ++r) o[d][r] *= al_l[crow(r, hi)]; } } while (0)
  f32x16 pA0, pA1, pB0, pB1; float mnA, mnB, alA, alB; bf16x8 pa0, pa1, pa2, pa3; const int NT = seq / KVBLK;
  constexpr int SE = 0, SO = SDEPTH - 1;
  SLOAD(SE, 0); asm volatile("s_waitcnt vmcnt(0)" ::: "memory"); SWRITE(0, SE); __syncthreads();
  qkt(pA0, pA1, K_lds, qr, r32, hi); partialSM(pA0, pA1, m_reg, mnA, alA);
  SLOAD(SO, KVBLK); if (2 < NT) SLOAD(SE, 2 * KVBLK);
  SWAIT(); SWRITE(1, SO); __syncthreads();
#pragma unroll 1
  for (int j = 1; j + 1 < NT; j += 2) {
    SBAR(); qkt(pB0, pB1, (bf16*)((char*)K_lds + SHM_K), qr, r32, hi);
    finishSM(pA0, pA1, alA, l_reg, pa0, pa1, pa2, pa3); SBAR();
    SLOAD(SO, (j + SDEPTH) * KVBLK); SBAR();
    pv_d0(o, vb0, pa0, pa1, pa2, pa3); partialSM(pB0, pB1, m_reg, mnB, alB);
    __syncthreads(); SWAIT(); SWRITE(0, SE);
    RESC(alB); __syncthreads();
    SBAR(); qkt(pA0, pA1, K_lds, qr, r32, hi);
    finishSM(pB0, pB1, alB, l_reg, pa0, pa1, pa2, pa3); SBAR();
    if (j + 3 < NT) SLOAD(SE, (j + 1 + SDEPTH) * KVBLK); SBAR();
    pv_d0(o, vb0 + (int)SHM_V, pa0, pa1, pa2, pa3); partialSM(pA0, pA1, m_reg, mnA, alA);
    __syncthreads(); SWAIT(); SWRITE(1, SO);
    RESC(alA); __syncthreads();
  }
  SBAR(); qkt(pB0, pB1, (bf16*)((char*)K_lds + SHM_K), qr, r32, hi);
  finishSM(pA0, pA1, alA, l_reg, pa0, pa1, pa2, pa3); SBAR();
  pv_d0(o, vb0, pa0, pa1, pa2, pa3); partialSM(pB0, pB1, m_reg, mnB, alB);
  __syncthreads(); RESC(alB);
  finishSM(pB0, pB1, alB, l_reg, pa0, pa1, pa2, pa3); SBAR();
  pv_d0(o, vb0 + (int)SHM_V, pa0, pa1, pa2, pa3);
  if (hi == 0) li_l[r32] = l_reg; asm volatile("s_waitcnt lgkmcnt(0)" ::: "memory");
  float rli[16];
#pragma unroll
  for (int r = 0; r < 16; ++r) rli[r] = __builtin_amdgcn_rcpf(li_l[crow(r, hi)]);
  unsigned short* Ow = Ob + (long)(wid * QBLK) * LDO;
#pragma unroll
  for (int r = 0; r < 16; ++r) { int orow = crow(r, hi);
#pragma unroll
    for (int d0 = 0; d0 < 4; ++d0) { const float v = o[d0][r] * rli[r]; Ow[(long)orow * LDO + d0 * 32 + r32] = (unsigned short)(cvtpk(v, v) & 0xffffu); } }
#undef SLOAD
#undef SWRITE
#undef SWAIT
#undef RESC
}
#undef KSWZ
#undef SBAR
}


#define XB_TMO      128
#define XB_XCNT(j)  (256  + 64 * (j))
#define XB_XSUB(j)  (1280 + 64 * (j))
#define XB_XGEN(j)  (2304 + 64 * (j))
#define XB_TOP      3328
#define XB_TOPGEN   3392
#define XCD_BAR_WORDS 3456
#define XB_SPIN_CAP (1u << 22)
__device__ __forceinline__ unsigned xb_ld(unsigned* p)              { return __hip_atomic_load(p, __ATOMIC_RELAXED, __HIP_MEMORY_SCOPE_AGENT); }
__device__ __forceinline__ unsigned xb_add(unsigned* p, unsigned v) { return __hip_atomic_fetch_add(p, v, __ATOMIC_RELAXED, __HIP_MEMORY_SCOPE_AGENT); }
__device__ __forceinline__ unsigned xb_xcc_id() { return (unsigned)__builtin_amdgcn_s_getreg((3 << 11) | 20) & 0xFu; }
#define XB_SPIN(cond, bar) do { unsigned _sp = 0; while (cond) { __builtin_amdgcn_s_sleep(1); \
    if ((++_sp & 255u) == 0u) { if (xb_ld(&(bar)[XB_TMO])) break; if (_sp > XB_SPIN_CAP) { atomicAdd(&(bar)[XB_TMO], 1u); break; } } } } while (0)
struct XcdBarrier { unsigned* bar; unsigned x; volatile __attribute__((address_space(3))) unsigned* st; };
__device__ __forceinline__ XcdBarrier xcd_barrier_post(unsigned* bar, volatile __attribute__((address_space(3))) unsigned* st) {
    XcdBarrier b; b.bar = bar; b.x = xb_xcc_id(); b.st = st;
    if (threadIdx.x == 0) (void)xb_add(&bar[XB_XCNT(b.x)], 1u);
    return b;
}
__device__ __forceinline__ void xcd_barrier_complete(unsigned* bar, unsigned x, unsigned& nloc, unsigned& nx) {
    const unsigned G = gridDim.x * gridDim.y * gridDim.z;
    unsigned sum, cnt, mine, sp = 0u;
    for (;;) {
        sum = 0u; cnt = 0u; mine = 0u;
#pragma unroll
        for (unsigned j = 0; j < 16; ++j) { const unsigned c = xb_ld(&bar[XB_XCNT(j)]); sum += c; cnt += (c > 0u) ? 1u : 0u; mine = (j == x) ? c : mine; }
        if (sum == G) break;
        __builtin_amdgcn_s_sleep(1);
        if ((++sp & 255u) == 0u) { if (xb_ld(&bar[XB_TMO])) break; if (sp > XB_SPIN_CAP) { atomicAdd(&bar[XB_TMO], 1u); break; } }
    }
    nloc = mine > 0u ? mine : 1u; nx = cnt > 0u ? cnt : 1u;
}
__device__ __forceinline__ void xcd_barrier(const XcdBarrier& b) {
    asm volatile("s_waitcnt vmcnt(0)" ::: "memory");
    __syncthreads();
    if (threadIdx.x == 0) {
        unsigned* bar = b.bar;
        __builtin_amdgcn_s_waitcnt(0);
        unsigned nloc = b.st[0], nx = b.st[1];
        if (nloc == 0u) { xcd_barrier_complete(bar, b.x, nloc, nx); b.st[0] = nloc; b.st[1] = nx; }
        const unsigned old = xb_add(&bar[XB_XSUB(b.x)], 1u);
        const unsigned gen = old / nloc;
        if (old + 1u == (gen + 1u) * nloc) {
            __builtin_amdgcn_fence(__ATOMIC_RELEASE, "agent");
            asm volatile("s_waitcnt vmcnt(0)" ::: "memory");
            const unsigned og = xb_add(&bar[XB_TOP], 1u);
            const unsigned tg = og / nx;
            if (og + 1u == (tg + 1u) * nx) xb_add(&bar[XB_TOPGEN], 1u);
            else XB_SPIN(xb_ld(&bar[XB_TOPGEN]) == tg, bar);
            __builtin_amdgcn_fence(__ATOMIC_ACQUIRE, "agent");
            xb_add(&bar[XB_XGEN(b.x)], 1u);
            asm volatile("s_waitcnt vmcnt(0)" ::: "memory");
        } else {
            XB_SPIN(xb_ld(&bar[XB_XGEN(b.x)]) == gen, bar);
            __builtin_amdgcn_fence(__ATOMIC_ACQUIRE, "agent");
            asm volatile("s_waitcnt vmcnt(0)" ::: "memory");
        }
    }
    __syncthreads();
}

constexpr int DM = 2048, NB = 8, SEQ = 2048, CTXL = 256, PROJ = 2560, DFF = 5632, NMOD = 6 * DM, SKV = CTXL + SEQ;
constexpr int ML = NB * SEQ, MC = NB * CTXL, MT = ML + MC;
constexpr float EPS = 1e-6f;
constexpr int NWAVES = 8, NTHREADS = 512;
constexpr int LDS_BYTES = 147456;
constexpr size_t MiB = 1u << 20;
constexpr size_t WS_MODP = 0;
constexpr size_t WS_MODF = 2 * MiB;
constexpr size_t WS_BAR = 2 * MiB + 768 * 1024, BAR_BYTES = 16384;
constexpr size_t WS_WIN = 3 * MiB;
constexpr size_t WS_WOUT = 13 * MiB;
constexpr size_t WS_WGU = 21 * MiB;
constexpr size_t WS_WD = 65 * MiB;
constexpr size_t WS_PW = 87 * MiB;
constexpr size_t WS_A = 88 * MiB;
constexpr size_t WS_X1 = 160 * MiB;
constexpr size_t WS_P = 288 * MiB;
constexpr size_t WS_QN = 378 * MiB;
constexpr size_t WS_KALL = 410 * MiB;
constexpr size_t WS_VALL = 419 * MiB;
constexpr size_t WS_POOL = 428 * MiB;
constexpr size_t WS_H = 288 * MiB;
constexpr size_t WS_END = 464 * MiB;

typedef unsigned short bf16raw;
typedef float f32x4 __attribute__((ext_vector_type(4)));
typedef unsigned u32x4 __attribute__((ext_vector_type(4)));
typedef unsigned u32x2 __attribute__((ext_vector_type(2)));
#define LAS __attribute__((address_space(3)))

__device__ __forceinline__ unsigned f2bf(float f) { unsigned u = __builtin_bit_cast(unsigned, f); return (u + 0x7fffu + ((u >> 16) & 1u)) >> 16; }
__device__ __forceinline__ unsigned pk2(float lo, float hi) { return f2bf(lo) | (f2bf(hi) << 16); }
__device__ __forceinline__ float bflo(unsigned w) { return __builtin_bit_cast(float, w << 16); }
__device__ __forceinline__ float bfhi(unsigned w) { return __builtin_bit_cast(float, w & 0xffff0000u); }
__device__ __forceinline__ float wave_sum(float v) {
#pragma unroll
    for (int o = 1; o < 64; o <<= 1) v += __shfl_xor(v, o);
    return v;
}

struct Args { const float* in[18]; float* out; unsigned char* ws; int ph_lo, ph_hi; };
enum { I_X = 0, I_C, I_CTX, I_CCTX, I_WADA, I_BADA, I_NMIX, I_NFFN, I_WIN, I_POOLW, I_POOLS, I_QN, I_KN, I_WOUT, I_WG, I_WU, I_WD, I_FN };

__device__ __forceinline__ void transpose_item(const float* W, int K, int N, bf16raw* WT, int k0, int n0, int drow0, LAS float* scr, int lane) {
#pragma unroll 8
    for (int i = 0; i < 32; ++i) { const int kk = 2 * i + (lane >> 5); scr[kk * 33 + (lane & 31)] = W[(size_t)(k0 + kk) * N + n0 + (lane & 31)]; }
    asm volatile("s_waitcnt lgkmcnt(0)" ::: "memory");
    const int c = lane & 7;
#pragma unroll
    for (int j = 0; j < 4; ++j) { const int n = (lane >> 3) + 8 * j; const LAS float* s = scr + (8 * c) * 33 + n;
        u32x4 o; o.x = pk2(s[0 * 33], s[1 * 33]); o.y = pk2(s[2 * 33], s[3 * 33]); o.z = pk2(s[4 * 33], s[5 * 33]); o.w = pk2(s[6 * 33], s[7 * 33]);
        *(u32x4*)(WT + (size_t)(drow0 + n) * K + k0 + 8 * c) = o; }
    asm volatile("s_waitcnt lgkmcnt(0)" ::: "memory");
}

__device__ __forceinline__ void norm_row_bf16(const float* xrow, bf16raw* orow, const LAS float* scale, const LAS float* shift, int lane) {
    const f32x4* xr = (const f32x4*)xrow + lane;
    f32x4 v[8]; float s = 0.f;
#pragma unroll
    for (int j = 0; j < 8; ++j) { v[j] = xr[64 * j]; s += (v[j].x * v[j].x + v[j].y * v[j].y) + (v[j].z * v[j].z + v[j].w * v[j].w); }
    const float rstd = 1.0f / sqrtf(wave_sum(s) * (1.f / DM) + EPS);
    u32x2* o8 = (u32x2*)orow + lane;
#pragma unroll
    for (int j = 0; j < 8; ++j) { const f32x4 sc = *((const LAS f32x4*)scale + lane + 64 * j), sh = *((const LAS f32x4*)shift + lane + 64 * j);
        const f32x4 y = v[j] * rstd * sc + sh; u32x2 w; w.x = pk2(y.x, y.y); w.y = pk2(y.z, y.w); o8[64 * j] = w; }
}

__global__ void __launch_bounds__(NTHREADS, 2) fwd_megakernel(Args a) {
    extern __shared__ __attribute__((aligned(16))) unsigned char lds[];
    cg::grid_group grid = cg::this_grid();
    const int G = gridDim.x, bx = blockIdx.x;
    const int vcu = (G % 8 == 0) ? (bx % 8) * (G / 8) + bx / 8 : bx;
    const int NGW = G * NWAVES;
#define PHASE_IDS() const int tid = opaque_tid(), lane = tid & 63, wave = __builtin_amdgcn_readfirstlane(tid >> 6), gw = vcu * NWAVES + wave; (void)lane; (void)gw
    typedef const Args __attribute__((address_space(4)))* CArgsP;
    const CArgsP ap0 = (CArgsP)__builtin_amdgcn_kernarg_segment_ptr();
#define ARGP() ({ CArgsP p_ = ap0; asm volatile("" : "+s"(p_)); p_; })
#define INP(i) (ARGP()->in[i])
    unsigned char* ws = ARGP()->ws;
    float* MODP = (float*)(ws + WS_MODP); float* MODF = (float*)(ws + WS_MODF);
    bf16raw* WinT = (bf16raw*)(ws + WS_WIN); bf16raw* WoutT = (bf16raw*)(ws + WS_WOUT); bf16raw* WguT = (bf16raw*)(ws + WS_WGU);
    bf16raw* WdT = (bf16raw*)(ws + WS_WD); bf16raw* PwT = (bf16raw*)(ws + WS_PW);
    bf16raw* ABUF = (bf16raw*)(ws + WS_A); float* X1 = (float*)(ws + WS_X1);
    bf16raw* PB = (bf16raw*)(ws + WS_P); bf16raw* QN = (bf16raw*)(ws + WS_QN); bf16raw* KALL = (bf16raw*)(ws + WS_KALL); bf16raw* VALL = (bf16raw*)(ws + WS_VALL);
    bf16raw* POOLED = (bf16raw*)(ws + WS_POOL); bf16raw* HB = (bf16raw*)(ws + WS_H);
    const int lo = ap0->ph_lo, hi = ap0->ph_hi;
    volatile LAS unsigned* bst = (volatile LAS unsigned*)(lds + 131072 + 512);
    if (threadIdx.x < 2) bst[threadIdx.x] = 0u;
    __syncthreads();
    XcdBarrier xbar; xbar.bar = (unsigned*)(ws + WS_BAR); xbar.x = 0; xbar.st = bst;
    if (hi - lo > 1) xbar = xcd_barrier_post((unsigned*)(ws + WS_BAR), bst);
    if (lo < 0) grid.sync();
#ifndef PHMASK
#define PHMASK 0x3ff
#endif
#define IN(k) (((PHMASK >> (k)) & 1) && lo <= (k) && (k) < hi)
#define SEAM(k) do { if (IN(k) && IN((k) + 1)) xcd_barrier(xbar); } while (0)

    if (IN(0)) {
        PHASE_IDS();
        {
            LAS float* silv = (LAS float*)lds;
            LAS float* red = (LAS float*)(lds + 9 * 512 * 4);
            const float* wada = INP(I_WADA);
            for (int u = bx; u < 192; u += G) {
                const int ks = u / 48, cgp = u % 48;
                for (int i = tid; i < 9 * 512; i += NTHREADS) { const int r = i >> 9, k = i & 511;
                    const float v = (r < 8) ? INP(I_C)[r * DM + ks * 512 + k] : INP(I_CCTX)[ks * 512 + k];
                    silv[i] = v / (1.0f + __expf(-v)); }
                __syncthreads();
                f32x4 acc[9];
#pragma unroll
                for (int r = 0; r < 9; ++r) acc[r] = (f32x4){0.f, 0.f, 0.f, 0.f};
                const float* wp = wada + (size_t)(ks * 512 + wave * 64) * NMOD + cgp * 256 + lane * 4;
                for (int kk = 0; kk < 64; kk += 8) {
                    f32x4 wv[8];
#pragma unroll
                    for (int j = 0; j < 8; ++j) wv[j] = *(const f32x4*)(wp + (size_t)(kk + j) * NMOD);
#pragma unroll
                    for (int r = 0; r < 9; ++r) {
                        const f32x4 s0 = *(const LAS f32x4*)(silv + r * 512 + wave * 64 + kk), s1 = *(const LAS f32x4*)(silv + r * 512 + wave * 64 + kk + 4);
                        acc[r] += s0.x * wv[0]; acc[r] += s0.y * wv[1]; acc[r] += s0.z * wv[2]; acc[r] += s0.w * wv[3];
                        acc[r] += s1.x * wv[4]; acc[r] += s1.y * wv[5]; acc[r] += s1.z * wv[6]; acc[r] += s1.w * wv[7];
                    }
                }
#pragma unroll
                for (int r = 0; r < 9; ++r) *(LAS f32x4*)(red + (wave * 9 + r) * 256 + lane * 4) = acc[r];
                __syncthreads();
                for (int i = tid; i < 9 * 64; i += NTHREADS) { const int r = i >> 6, l = i & 63; f32x4 s = (f32x4){0.f, 0.f, 0.f, 0.f};
#pragma unroll
                    for (int w = 0; w < 8; ++w) s += *(const LAS f32x4*)(red + (w * 9 + r) * 256 + l * 4);
                    *(f32x4*)(MODP + (size_t)(ks * 9 + r) * NMOD + cgp * 256 + l * 4) = s; }
                __syncthreads();
            }
        }
        {
            LAS float* scr = (LAS float*)(lds + wave * 16384);
            constexpr int I_IN = 32 * 80, I_OUT = 32 * 64, I_G = 32 * 176, I_D = 88 * 64, I_P = 4 * 32;
            constexpr int NITEMS = I_IN + I_OUT + 2 * I_G + I_D + I_P;
            for (int it = gw; it < NITEMS; it += NGW) {
                int r = it;
                if (r < I_IN) { const int kb = r / 80, nb = r % 80; transpose_item(INP(I_WIN), DM, PROJ, WinT, kb * 64, nb * 32, nb * 32, scr, lane); continue; } r -= I_IN;
                if (r < I_OUT) { const int kb = r / 64, nb = r % 64; transpose_item(INP(I_WOUT), DM, DM, WoutT, kb * 64, nb * 32, nb * 32, scr, lane); continue; } r -= I_OUT;
                if (r < I_G) { const int kb = r / 176, nb = r % 176, n0 = nb * 32; transpose_item(INP(I_WG), DM, DFF, WguT, kb * 64, n0, (n0 >> 7) * 256 + (n0 & 127), scr, lane); continue; } r -= I_G;
                if (r < I_G) { const int kb = r / 176, nb = r % 176, n0 = nb * 32; transpose_item(INP(I_WU), DM, DFF, WguT, kb * 64, n0, (n0 >> 7) * 256 + 128 + (n0 & 127), scr, lane); continue; } r -= I_G;
                if (r < I_D) { const int kb = r / 64, nb = r % 64; transpose_item(INP(I_WD), DFF, DM, WdT, kb * 64, nb * 32, nb * 32, scr, lane); continue; } r -= I_D;
                { const int g = r / 32, q = r % 32, kb = q / 8, nb = q % 8; transpose_item(INP(I_POOLW) + (size_t)g * 65536, 256, 256, PwT + (size_t)g * 65536, kb * 64, nb * 32, nb * 32, scr, lane); }
            }
        }
    }
    SEAM(0);

    if (IN(1)) {
        PHASE_IDS();
        for (int i = bx * NTHREADS + tid; i < 9 * NMOD; i += G * NTHREADS) { const int col = i % NMOD;
            MODF[i] = INP(I_BADA)[col] + ((MODP[i] + MODP[9 * NMOD + i]) + (MODP[2 * 9 * NMOD + i] + MODP[3 * 9 * NMOD + i])); }
        LAS float* scale = (LAS float*)lds; LAS float* shift = (LAS float*)(lds + DM * 4);
        constexpr int NCH = MT / 8;
        const int c0 = (int)((long)bx * NCH / G), c1 = (int)((long)(bx + 1) * NCH / G);
        int curb = -1;
        for (int ch = c0; ch < c1; ++ch) {
            const int row = ch * 8 + wave; const int b = (row < ML) ? (row >> 11) : 8;
            if (b != curb) { __syncthreads();
                for (int col = tid; col < DM; col += NTHREADS) { float shv = INP(I_BADA)[col], scv = INP(I_BADA)[DM + col];
#pragma unroll
                    for (int ks = 0; ks < 4; ++ks) { shv += MODP[(size_t)(ks * 9 + b) * NMOD + col]; scv += MODP[(size_t)(ks * 9 + b) * NMOD + DM + col]; }
                    scale[col] = INP(I_NMIX)[col] * (1.0f + scv); shift[col] = shv; }
                __syncthreads(); curb = b; }
            const float* src = (row < ML) ? INP(I_X) + (size_t)row * DM : INP(I_CTX) + (size_t)(row - ML) * DM;
            norm_row_bf16(src, ABUF + (size_t)row * DM, scale, shift, lane);
        }
    }
    SEAM(1);

    if (IN(2)) {
        pg8::Gemm g{ABUF, WinT, MT, PROJ, DM, DM, DM, 0}; pg8::StaticOrder S; S.init(MT, PROJ, G, bx);
        pg8::EpiBf16<false> E{PB, PROJ, nullptr};
        pg8::gemm_phase<pg8::EpiBf16<false>, pg8::StaticOrder, true>((LAS unsigned char*)lds, g, S, E);
    }
    SEAM(2);

    if (IN(3)) {
        PHASE_IDS();
        {
            const int sub = lane >> 4, s = lane & 15;
            constexpr long NLAT = (long)ML * 12, NIT = NLAT + (long)MC * 4;
            for (long base = (long)gw * 4; base < NIT; base += (long)NGW * 4) {
                const long idx = base + sub; int row, it;
                if (idx < NLAT) { row = (int)(idx / 12); it = (int)(idx % 12); } else { const long j = idx - NLAT; row = ML + (int)(j >> 2); it = 8 + (int)(j & 3); }
                const u32x4 raw = *(const u32x4*)(PB + (size_t)row * PROJ + 1024 + it * 128 + s * 8);
                const bool lat = row < ML; int b, spos, t = 0;
                if (lat) { b = row >> 11; t = row & 2047; spos = CTXL + t; } else { const int r = row - ML; b = r >> 8; spos = r & 255; }
                float v[8] = {bflo(raw.x), bfhi(raw.x), bflo(raw.y), bfhi(raw.y), bflo(raw.z), bfhi(raw.z), bflo(raw.w), bfhi(raw.w)};
                float ss = 0.f;
#pragma unroll
                for (int i = 0; i < 8; ++i) ss += v[i] * v[i];
                ss += __shfl_xor(ss, 1); ss += __shfl_xor(ss, 2); ss += __shfl_xor(ss, 4); ss += __shfl_xor(ss, 8);
                const float rstd = 1.0f / sqrtf(ss * (1.f / 128.f) + EPS);
                const float* gn = (it < 8 ? INP(I_QN) : INP(I_KN)) + s * 8;
                const f32x4 g0 = *(const f32x4*)gn, g1 = *(const f32x4*)(gn + 4);
                float y[8] = {v[0] * rstd * g0.x, v[1] * rstd * g0.y, v[2] * rstd * g0.z, v[3] * rstd * g0.w, v[4] * rstd * g1.x, v[5] * rstd * g1.y, v[6] * rstd * g1.z, v[7] * rstd * g1.w};
                if (lat) {
#pragma unroll
                    for (int p = 0; p < 4; ++p) { const int i = s * 4 + p, j = i & 31; const float pos = (float)((i < 32) ? (t >> 6) : (t & 63));
                        const float freq = __builtin_amdgcn_exp2f(-(float)(2 * j) * (13.287712379549449f / 64.f));
                        const float rev = (pos * freq) * 0.15915494309189535f;
                        const float cs = __builtin_amdgcn_cosf(rev), sn = __builtin_amdgcn_sinf(rev);
                        const float x1 = y[2 * p], x2 = y[2 * p + 1]; y[2 * p] = x1 * cs - x2 * sn; y[2 * p + 1] = x1 * sn + x2 * cs; }
                }
                u32x4 w; w.x = pk2(y[0], y[1]); w.y = pk2(y[2], y[3]); w.z = pk2(y[4], y[5]); w.w = pk2(y[6], y[7]);
                if (it < 8) *(u32x4*)(QN + (size_t)row * 1024 + it * 128 + s * 8) = w;
                else if (it < 10) *(u32x4*)(KALL + ((size_t)b * SKV + spos) * 256 + (it - 8) * 128 + s * 8) = w;
                else *(u32x4*)(VALL + ((size_t)b * SKV + spos) * 256 + (it - 10) * 128 + s * 8) = raw;
            }
        }
        {
            const long nth = (long)G * NTHREADS;
            for (long i = (long)vcu * NTHREADS + tid; i < (long)ML * 128; i += nth) {
                const int row = (int)(i >> 7), ch = (int)(i & 127), gidx = ch >> 5, half = 1 << gidx, t = row & 2047;
                const int tlo = (t - half < 0) ? 0 : t - half, thi = (t + half > SEQ) ? SEQ : t + half;
                const bf16raw* pbase = PB + (size_t)(row - t) * PROJ + ch * 8;
                float acc[8] = {0.f, 0.f, 0.f, 0.f, 0.f, 0.f, 0.f, 0.f};
                for (int tt = tlo; tt < thi; ++tt) { const u32x4 r = *(const u32x4*)(pbase + (size_t)tt * PROJ);
                    acc[0] += bflo(r.x); acc[1] += bfhi(r.x); acc[2] += bflo(r.y); acc[3] += bfhi(r.y); acc[4] += bflo(r.z); acc[5] += bfhi(r.z); acc[6] += bflo(r.w); acc[7] += bfhi(r.w); }
                const u32x4 me = *(const u32x4*)(pbase + (size_t)t * PROJ); const float inv = 1.0f / (float)(thi - tlo);
                u32x4 w; w.x = pk2(acc[0] * inv - bflo(me.x), acc[1] * inv - bfhi(me.x)); w.y = pk2(acc[2] * inv - bflo(me.y), acc[3] * inv - bfhi(me.y));
                w.z = pk2(acc[4] * inv - bflo(me.z), acc[5] * inv - bfhi(me.z)); w.w = pk2(acc[6] * inv - bflo(me.w), acc[7] * inv - bfhi(me.w));
                *(u32x4*)(POOLED + (size_t)row * 1024 + ch * 8) = w;
            }
        }
    }
    SEAM(3);

    if (IN(4)) {
#ifndef NO_ATT
        for (int unit = vcu; unit < 512; unit += G) {
            const int pair = unit >> 5, b = pair >> 1, kvh = pair & 1, r = unit & 31, gq = r >> 3, qb = r & 7, h = kvh * 4 + gq;
            att::attn_dense_body((const att::bf16*)(QN + ((size_t)b * SEQ + qb * 256) * 1024 + h * 128),
                                 (const att::bf16*)(KALL + (size_t)b * SKV * 256 + kvh * 128), (const att::bf16*)(VALL + (size_t)b * SKV * 256 + kvh * 128),
                                 ABUF + ((size_t)b * SEQ + qb * 256) * 2048 + 1024 + h * 128, SKV, (char*)lds);
            __syncthreads();
        }
#endif
#ifndef NO_POOLG
        {
        pg8::Gemm g{POOLED, PwT, ML, 1024, 256, 1024, 256, 256}; pg8::StaticOrder S; S.init(ML, 1024, G, bx);
        pg8::EpiBf16<true> E{ABUF, 2048, INP(I_POOLS)};
        pg8::gemm_phase<pg8::EpiBf16<true>, pg8::StaticOrder, true>((LAS unsigned char*)lds, g, S, E);
        }
#endif
    }
    SEAM(4);

    if (IN(5)) {
        pg8::Gemm g{ABUF, WoutT, ML, DM, DM, DM, DM, 0}; pg8::StaticOrder S; S.init(ML, DM, G, bx);
        pg8::EpiRes E{INP(I_X), X1, MODF + 2 * DM};
        pg8::gemm_phase<pg8::EpiRes, pg8::StaticOrder, true>((LAS unsigned char*)lds, g, S, E);
    }
    SEAM(5);

    if (IN(6)) {
        PHASE_IDS();
        LAS float* scale = (LAS float*)lds; LAS float* shift = (LAS float*)(lds + DM * 4);
        constexpr int NCH = ML / 8;
        const int c0 = (int)((long)bx * NCH / G), c1 = (int)((long)(bx + 1) * NCH / G);
        int curb = -1;
        for (int ch = c0; ch < c1; ++ch) {
            const int row = ch * 8 + wave; const int b = row >> 11;
            if (b != curb) { __syncthreads();
                for (int col = tid; col < DM; col += NTHREADS) { scale[col] = INP(I_NFFN)[col] * (1.0f + MODF[(size_t)b * NMOD + 4 * DM + col]); shift[col] = MODF[(size_t)b * NMOD + 3 * DM + col]; }
                __syncthreads(); curb = b; }
            norm_row_bf16(X1 + (size_t)row * DM, ABUF + (size_t)row * DM, scale, shift, lane);
        }
    }
    SEAM(6);

    if (IN(7)) {
        pg8::Gemm g{ABUF, WguT, ML, 2 * DFF, DM, DM, DM, 0}; pg8::StaticOrder S; S.init(ML, 2 * DFF, G, bx);
        pg8::EpiSwiGLU E{HB, DFF};
        pg8::gemm_phase<pg8::EpiSwiGLU, pg8::StaticOrder, true>((LAS unsigned char*)lds, g, S, E);
    }
    SEAM(7);

    if (IN(8)) {
        pg8::Gemm g{HB, WdT, ML, DM, DFF, DFF, DFF, 0}; pg8::StaticOrder S; S.init(ML, DM, G, bx);
        pg8::EpiRes E{X1, X1, MODF + 5 * DM};
        pg8::gemm_phase<pg8::EpiRes, pg8::StaticOrder, true>((LAS unsigned char*)lds, g, S, E);
    }
    SEAM(8);

    if (IN(9)) {
        PHASE_IDS();
        const float* fn = INP(I_FN);
        for (int row = gw; row < ML; row += NGW) {
            const f32x4* xr = (const f32x4*)(X1 + (size_t)row * DM) + lane;
            f32x4 v[8]; float s = 0.f;
#pragma unroll
            for (int j = 0; j < 8; ++j) { v[j] = xr[64 * j]; s += (v[j].x * v[j].x + v[j].y * v[j].y) + (v[j].z * v[j].z + v[j].w * v[j].w); }
            const float rstd = 1.0f / sqrtf(wave_sum(s) * (1.f / DM) + EPS);
            f32x4* orow = (f32x4*)(ARGP()->out + (size_t)row * DM) + lane;
#pragma unroll
            for (int j = 0; j < 8; ++j) orow[64 * j] = v[j] * rstd * *((const f32x4*)fn + lane + 64 * j);
        }
    }
#undef IN
#undef SEAM
}

extern "C" void kernel_launch(void* const* d_in, const int* in_sizes, int n_in, void* d_out, int out_size, void* d_ws, size_t ws_size, hipStream_t stream) {
    static int grid = 0;
    if (grid == 0) {
        if (n_in != 18 || in_sizes[0] != ML * DM || out_size != ML * DM || ws_size < WS_END) {
            fprintf(stderr, "kernel_launch: shape mismatch: n_in %d in0 %d out %d ws %zu (need >= %zu)\n", n_in, n_in > 0 ? in_sizes[0] : -1, out_size, ws_size, (size_t)WS_END); grid = -1; return; }
        int dev = 0, cus = 0, per_cu = 0;
        if (hipGetDevice(&dev) != hipSuccess || hipDeviceGetAttribute(&cus, hipDeviceAttributeMultiprocessorCount, dev) != hipSuccess) { fprintf(stderr, "kernel_launch: device query failed\n"); grid = -1; return; }
        if (hipFuncSetAttribute((const void*)fwd_megakernel, hipFuncAttributeMaxDynamicSharedMemorySize, LDS_BYTES) != hipSuccess) { fprintf(stderr, "kernel_launch: hipFuncSetAttribute failed\n"); grid = -1; return; }
        if (hipOccupancyMaxActiveBlocksPerMultiprocessor(&per_cu, (const void*)fwd_megakernel, NTHREADS, LDS_BYTES) != hipSuccess || per_cu < 1) {
            fprintf(stderr, "kernel_launch: occupancy query reports %d blocks per CU\n", per_cu); (void)hipGetLastError(); per_cu = 1; }
        grid = cus * 1;
        fprintf(stderr, "kernel_launch: cus %d per_cu %d grid %d\n", cus, per_cu, grid);
    }
    if (grid < 0) return;
    if (hipMemsetAsync((char*)d_ws + WS_BAR, 0, BAR_BYTES, stream) != hipSuccess) { fprintf(stderr, "kernel_launch: memset of barrier words failed\n"); return; }
    Args a{};
    for (int i = 0; i < 18; ++i) a.in[i] = (const float*)d_in[i];
    a.out = (float*)d_out; a.ws = (unsigned char*)d_ws;
#if MK_MULTI
    for (int ph = 0; ph < 10; ++ph) { a.ph_lo = ph; a.ph_hi = ph + 1; hipLaunchKernelGGL(fwd_megakernel, dim3(grid), dim3(NTHREADS), LDS_BYTES, stream, a); }
#else
    a.ph_lo = 0; a.ph_hi = 10;
    void* args[] = {&a};
    hipError_t e = hipLaunchCooperativeKernel((void*)fwd_megakernel, dim3(grid), dim3(NTHREADS), args, LDS_BYTES, stream);
    if (e != hipSuccess) fprintf(stderr, "kernel_launch: cooperative launch failed: %s (grid %d)\n", hipGetErrorString(e), grid);
#endif
}
```
